# Optimizing an MI355X kernel written in HIP

```python
import math
import jax, jax.numpy as jnp
from jax import lax
import numpy as np

D_MODEL = 1024
BATCH = 8
SEQ = 2048
DEPTH = 4

D_PLE = 256
N_A_LAYERS = DEPTH // 2
N_B_LAYERS = DEPTH - N_A_LAYERS
N_DENSE = (DEPTH + 1) // 2
N_MOE = DEPTH // 2
EPS = 1e-6

D_RNN = D_MODEL
CONV_WIDTH = 4
LRU_BLOCKS = 16
LRU_BLOCK_W = D_RNN // LRU_BLOCKS
LRU_C = 8.0

N_HEADS = 16
N_KV_GROUPS = 2
GROUP = N_HEADS // N_KV_GROUPS
HEAD_DIM = 64
N_KV_BRANCH = 6
CMP_BLOCK = 32
CMP_STRIDE = 16
CMP_HIDDEN = 256
SLC_BLOCK = 64
N_SELECT = 8
WINDOW = 512
Q_BLOCK = 128

N_BUCKETS = 32
MAX_DISTANCE = 128

D_FF = 3072
N_EXPERTS = 8
TOP_K = 2
D_FF_EXPERT = 3584

kernel_name = 'hybrid_rglru_nsa_moe_trunk'


def rmsnorm(x, g):
    xf = x.astype(jnp.float32)
    y = xf * lax.rsqrt(jnp.mean(xf * xf, axis=-1, keepdims=True) + EPS)
    return (y * g.astype(jnp.float32)).astype(x.dtype)


def masked_softmax(logits, mask):
    l = jnp.where(mask, logits.astype(jnp.float32), -1e30)
    m = jnp.max(l, axis=-1, keepdims=True)
    e = jnp.where(mask, jnp.exp(l - m), 0.0)
    return e / jnp.maximum(jnp.sum(e, axis=-1, keepdims=True), 1e-30)


def rel_bucket(dist):
    n = jnp.maximum(dist, 0)
    max_exact = N_BUCKETS // 2
    nf = jnp.maximum(n, 1).astype(jnp.float32)
    large = max_exact + (jnp.log(nf / max_exact) / math.log(MAX_DISTANCE / max_exact) * (N_BUCKETS - max_exact)).astype(jnp.int32)
    return jnp.where(n < max_exact, n, jnp.minimum(large, N_BUCKETS - 1))


def causal_dwconv(x, w, b):
    S = x.shape[1]
    xp = jnp.pad(x, ((0, 0), (CONV_WIDTH - 1, 0), (0, 0)))
    return sum(xp[:, k:k + S] * w[k] for k in range(CONV_WIDTH)) + b


def block_diag_linear(x, w, b):
    xb = x.reshape(x.shape[:-1] + (LRU_BLOCKS, LRU_BLOCK_W))
    return jnp.einsum('bsnc,ncd->bsnd', xb, w).reshape(x.shape) + b


def rg_lru(x, w_a, b_a, w_x, b_x, lam):
    f32 = jnp.float32
    r = jax.nn.sigmoid(block_diag_linear(x, w_a, b_a)).astype(f32)
    i = jax.nn.sigmoid(block_diag_linear(x, w_x, b_x)).astype(f32)
    log_a = -LRU_C * r * jax.nn.softplus(-lam.astype(f32))
    a = jnp.exp(log_a)
    u = jnp.sqrt(-jnp.expm1(2.0 * log_a)) * (i * x.astype(f32))

    def combine(c1, c2):
        a1, b1 = c1
        a2, b2 = c2
        return a1 * a2, a2 * b1 + b2

    _, h = lax.associative_scan(combine, (a, u), axis=1)
    return h.astype(x.dtype)


def recurrent_block(xn, w_in, conv_w, conv_b, w_a, b_a, w_x, b_x, lam, w_out):
    gate, xr = jnp.split(xn @ w_in, 2, axis=-1)
    xr = causal_dwconv(xr, conv_w, conv_b)
    h = rg_lru(xr, w_a, b_a, w_x, b_x, lam)
    return (jax.nn.gelu(gate) * h) @ w_out


def swiglu(x, w_gu, w_down):
    g, u = jnp.split(x @ w_gu, 2, axis=-1)
    return (jax.nn.silu(g) * u) @ w_down


def moe_ffn(x, w_router, w_gu, w_down):
    logits = (x @ w_router).astype(jnp.float32)
    top_val, top_idx = lax.top_k(logits, TOP_K)
    top_w = jax.nn.softmax(top_val, axis=-1)
    combine = jnp.sum(jax.nn.one_hot(top_idx, N_EXPERTS, dtype=jnp.float32) * top_w[..., None], axis=-2)
    combine = combine.astype(x.dtype)
    y = jnp.zeros_like(x)
    for e in range(N_EXPERTS):
        y = y + combine[..., e:e + 1] * swiglu(x, w_gu[e], w_down[e])
    return y


def nsa_shared_kv(x, kv_norm, w_kv, cmp_pos_k, cmp_pos_v, cmp_k_w1, cmp_k_w2, cmp_v_w1, cmp_v_w2):
    B, S, _ = x.shape
    kv = (rmsnorm(x, kv_norm) @ w_kv).reshape(B, S, N_KV_BRANCH, N_KV_GROUPS, HEAD_DIM)
    k_ct, v_ct, k_slc, v_slc, k_win, v_win = [kv[:, :, j] for j in range(N_KV_BRANCH)]
    n_cmp = (S - CMP_BLOCK) // CMP_STRIDE + 1
    idx = jnp.arange(n_cmp)[:, None] * CMP_STRIDE + jnp.arange(CMP_BLOCK)[None, :]

    def compress(t, pos_emb, w1, w2):
        blk = t[:, idx] + pos_emb[:, None, :]
        blk = blk.transpose(0, 1, 3, 2, 4).reshape(B, n_cmp, N_KV_GROUPS, CMP_BLOCK * HEAD_DIM)
        return jax.nn.gelu(blk @ w1) @ w2

    k_cmp = compress(k_ct, cmp_pos_k, cmp_k_w1, cmp_k_w2)
    v_cmp = compress(v_ct, cmp_pos_v, cmp_v_w1, cmp_v_w2)
    return (k_cmp, v_cmp, k_slc, v_slc, k_win, v_win)


def nsa_attention(xn, w_q, w_o, rel_bias, k_cmp, v_cmp, k_slc, v_slc, k_win, v_win):
    B, S, _ = xn.shape
    G, R, Dh = N_KV_GROUPS, GROUP, HEAD_DIM
    dt = xn.dtype
    proj = xn @ w_q
    q = proj[..., :N_HEADS * Dh].reshape(B, S, G, R, Dh) * (Dh ** -0.5)
    gates = jax.nn.sigmoid(proj[..., N_HEADS * Dh:].reshape(B, S, 3, G, R))
    pos = jnp.arange(S, dtype=jnp.int32)
    tbl = rel_bias.reshape(N_BUCKETS, G, R)

    n_cmp = k_cmp.shape[1]
    cmp_start = jnp.arange(n_cmp, dtype=jnp.int32) * CMP_STRIDE
    dist_c = pos[:, None] - (cmp_start + CMP_BLOCK - 1)[None, :]
    bias_c = tbl[rel_bucket(dist_c)].transpose(2, 3, 0, 1)
    s_c = jnp.einsum('bsgrd,bcgd->bgrsc', q, k_cmp) + bias_c
    p_c = masked_softmax(s_c, dist_c >= 0)
    o_cmp = jnp.einsum('bgrsc,bcgd->bsgrd', p_c.astype(dt), v_cmp)

    n_slc = S // SLC_BLOCK
    n_sel = min(N_SELECT, n_slc)
    slc_start = jnp.arange(n_slc, dtype=jnp.int32) * SLC_BLOCK
    overlap = ((cmp_start[:, None] < slc_start[None, :] + SLC_BLOCK) &
               (cmp_start[:, None] + CMP_BLOCK > slc_start[None, :])).astype(jnp.float32)
    imp = jnp.einsum('bgrsc,cj->bsgj', p_c, overlap)
    q_blk = (pos // SLC_BLOCK)[:, None]
    j = jnp.arange(n_slc, dtype=jnp.int32)[None, :]
    valid = (j <= q_blk)[:, None, :]
    forced = ((j == 0) | (j == q_blk) | (j == q_blk - 1))[:, None, :]
    score = jnp.where(forced, 1e9, jnp.where(valid, imp, -1e9))
    _, sel = lax.top_k(score, n_sel)

    n_qb = S // Q_BLOCK
    kb = k_slc.reshape(B, n_slc, SLC_BLOCK, G, Dh).transpose(0, 3, 1, 2, 4)
    vb = v_slc.reshape(B, n_slc, SLC_BLOCK, G, Dh).transpose(0, 3, 1, 2, 4)
    kw_pad = jnp.pad(k_win, ((0, 0), (WINDOW, 0), (0, 0), (0, 0)))
    vw_pad = jnp.pad(v_win, ((0, 0), (WINDOW, 0), (0, 0), (0, 0)))
    bi = jnp.arange(B)[:, None, None, None]
    gi = jnp.arange(G)[None, None, :, None]
    gi5 = gi[..., None]
    offs = jnp.arange(SLC_BLOCK, dtype=jnp.int32)
    band = jnp.arange(WINDOW + Q_BLOCK, dtype=jnp.int32)
    n_sel_tok = n_sel * SLC_BLOCK

    def block_fn(args):
        qb, selb, t0 = args
        tq = t0 + jnp.arange(Q_BLOCK, dtype=jnp.int32)
        ks = kb[bi, gi, selb]
        vs = vb[bi, gi, selb]
        dist_s = tq[None, :, None, None, None] - (selb[..., None] * SLC_BLOCK + offs)
        bias_s = tbl[rel_bucket(dist_s), gi5].transpose(0, 1, 2, 5, 3, 4)
        s_s = jnp.einsum('bqgrd,bqgnkd->bqgrnk', qb, ks) + bias_s
        s_s = s_s.reshape(B, Q_BLOCK, G, R, n_sel_tok)
        mask_s = (dist_s >= 0).reshape(B, Q_BLOCK, G, 1, n_sel_tok)
        p_s = masked_softmax(s_s, mask_s)
        o_s = jnp.einsum('bqgrk,bqgkd->bqgrd', p_s.astype(dt), vs.reshape(B, Q_BLOCK, G, n_sel_tok, Dh))

        kw = lax.dynamic_slice_in_dim(kw_pad, t0, WINDOW + Q_BLOCK, axis=1)
        vw = lax.dynamic_slice_in_dim(vw_pad, t0, WINDOW + Q_BLOCK, axis=1)
        kpos = t0 - WINDOW + band
        dist_w = tq[:, None] - kpos[None, :]
        mask_w = (dist_w >= 0) & (dist_w < WINDOW) & (kpos[None, :] >= 0)
        bias_w = tbl[rel_bucket(dist_w)].transpose(0, 2, 3, 1)
        s_w = jnp.einsum('bqgrd,bkgd->bqgrk', qb, kw) + bias_w
        p_w = masked_softmax(s_w, mask_w[:, None, None, :])
        o_w = jnp.einsum('bqgrk,bkgd->bqgrd', p_w.astype(dt), vw)
        return o_s, o_w

    q_blocks = jnp.moveaxis(q.reshape(B, n_qb, Q_BLOCK, G, R, Dh), 1, 0)
    sel_blocks = jnp.moveaxis(sel.reshape(B, n_qb, Q_BLOCK, G, n_sel), 1, 0)
    t0s = jnp.arange(n_qb, dtype=jnp.int32) * Q_BLOCK
    o_s, o_w = lax.map(block_fn, (q_blocks, sel_blocks, t0s))
    o_s = jnp.moveaxis(o_s, 0, 1).reshape(B, S, G, R, Dh)
    o_w = jnp.moveaxis(o_w, 0, 1).reshape(B, S, G, R, Dh)

    o = (gates[:, :, 0, :, :, None] * o_cmp + gates[:, :, 1, :, :, None] * o_s
         + gates[:, :, 2, :, :, None] * o_w)
    return o.reshape(B, S, N_HEADS * Dh) @ w_o


def setup_inputs(seed: int = 0) -> dict:
    key = jax.random.key(seed)
    keys = iter(jax.random.split(key, 48))
    f32 = jnp.float32

    def w(shape, fan_in):
        return jax.random.normal(next(keys), shape, f32) * (fan_in ** -0.5)

    def gain(shape):
        return 1.0 + 0.05 * jax.random.normal(next(keys), shape, f32)

    def small(shape, scale=0.01):
        return scale * jax.random.normal(next(keys), shape, f32)

    lru_s = jax.random.uniform(next(keys), (N_A_LAYERS, D_RNN), f32, 0.9, 0.999) ** (1.0 / LRU_C)
    d_q = N_HEADS * HEAD_DIM + 3 * N_HEADS
    return {
        'x': jax.random.normal(next(keys), (BATCH, SEQ, D_MODEL), f32),
        'p': jax.random.normal(next(keys), (DEPTH, BATCH, SEQ, D_PLE), f32),
        'g_mix': gain((DEPTH, D_MODEL)),
        'g_ffn': gain((DEPTH, D_MODEL)),
        'g_ple': gain((DEPTH, D_MODEL)),
        'g_final': gain((D_MODEL,)),
        'rg_w_in': w((N_A_LAYERS, D_MODEL, 2 * D_RNN), D_MODEL),
        'rg_conv_w': w((N_A_LAYERS, CONV_WIDTH, D_RNN), CONV_WIDTH),
        'rg_conv_b': small((N_A_LAYERS, D_RNN)),
        'rg_w_a': w((N_A_LAYERS, LRU_BLOCKS, LRU_BLOCK_W, LRU_BLOCK_W), LRU_BLOCK_W),
        'rg_b_a': small((N_A_LAYERS, D_RNN)),
        'rg_w_x': w((N_A_LAYERS, LRU_BLOCKS, LRU_BLOCK_W, LRU_BLOCK_W), LRU_BLOCK_W),
        'rg_b_x': small((N_A_LAYERS, D_RNN)),
        'rg_lambda': jnp.log(lru_s) - jnp.log1p(-lru_s),
        'rg_w_out': w((N_A_LAYERS, D_RNN, D_MODEL), D_RNN),
        'kv_norm': gain((D_MODEL,)),
        'w_kv': w((D_MODEL, N_KV_BRANCH * N_KV_GROUPS * HEAD_DIM), D_MODEL),
        'cmp_pos_k': small((CMP_BLOCK, HEAD_DIM), 0.1),
        'cmp_pos_v': small((CMP_BLOCK, HEAD_DIM), 0.1),
        'cmp_k_w1': w((CMP_BLOCK * HEAD_DIM, CMP_HIDDEN), CMP_BLOCK * HEAD_DIM),
        'cmp_k_w2': w((CMP_HIDDEN, HEAD_DIM), CMP_HIDDEN),
        'cmp_v_w1': w((CMP_BLOCK * HEAD_DIM, CMP_HIDDEN), CMP_BLOCK * HEAD_DIM),
        'cmp_v_w2': w((CMP_HIDDEN, HEAD_DIM), CMP_HIDDEN),
        'rel_bias': small((N_BUCKETS, N_HEADS), 0.3),
        'nsa_w_q': w((N_B_LAYERS, D_MODEL, d_q), D_MODEL),
        'nsa_w_o': w((N_B_LAYERS, N_HEADS * HEAD_DIM, D_MODEL), N_HEADS * HEAD_DIM),
        'ffn_w_gu': w((N_DENSE, D_MODEL, 2 * D_FF), D_MODEL),
        'ffn_w_down': w((N_DENSE, D_FF, D_MODEL), D_FF),
        'moe_w_router': w((N_MOE, D_MODEL, N_EXPERTS), D_MODEL),
        'moe_w_gu': w((N_MOE, N_EXPERTS, D_MODEL, 2 * D_FF_EXPERT), D_MODEL),
        'moe_w_down': w((N_MOE, N_EXPERTS, D_FF_EXPERT, D_MODEL), D_FF_EXPERT),
        'ple_w_proj': w((DEPTH, D_PLE, D_MODEL), D_PLE),
        'ple_w_gate': w((DEPTH, D_MODEL, D_MODEL), D_MODEL),
    }


def reference(x, p, g_mix, g_ffn, g_ple, g_final,
              rg_w_in, rg_conv_w, rg_conv_b, rg_w_a, rg_b_a, rg_w_x, rg_b_x, rg_lambda, rg_w_out,
              kv_norm, w_kv, cmp_pos_k, cmp_pos_v, cmp_k_w1, cmp_k_w2, cmp_v_w1, cmp_v_w2, rel_bias,
              nsa_w_q, nsa_w_o, ffn_w_gu, ffn_w_down, moe_w_router, moe_w_gu, moe_w_down,
              ple_w_proj, ple_w_gate):
    shared_kv = None
    for i in range(DEPTH):
        h = rmsnorm(x, g_mix[i])
        if i < N_A_LAYERS:
            a = i
            x = x + recurrent_block(h, rg_w_in[a], rg_conv_w[a], rg_conv_b[a], rg_w_a[a], rg_b_a[a],
                                    rg_w_x[a], rg_b_x[a], rg_lambda[a], rg_w_out[a])
        else:
            b = i - N_A_LAYERS
            x = x + nsa_attention(h, nsa_w_q[b], nsa_w_o[b], rel_bias, *shared_kv)
        h = rmsnorm(x, g_ffn[i])
        if i % 2 == 0:
            x = x + swiglu(h, ffn_w_gu[i // 2], ffn_w_down[i // 2])
        else:
            x = x + moe_ffn(h, moe_w_router[i // 2], moe_w_gu[i // 2], moe_w_down[i // 2])
        ple_gate = jax.nn.sigmoid(rmsnorm(x, g_ple[i]) @ ple_w_gate[i])
        x = x + ple_gate * (p[i] @ ple_w_proj[i])
        if i == N_A_LAYERS - 1:
            shared_kv = nsa_shared_kv(x, kv_norm, w_kv, cmp_pos_k, cmp_pos_v,
                                      cmp_k_w1, cmp_k_w2, cmp_v_w1, cmp_v_w2)
    return rmsnorm(x, g_final)
```

```cpp
#include <hip/hip_runtime.h>
#include <cstdio>
#include <cstdint>

#ifndef MK_DUPMASK
#define MK_DUPMASK 0u
#endif
#define DUP(k) ((MK_DUPMASK >> (k)) & 1u)
#define GAS __attribute__((address_space(1)))
#define LAS __attribute__((address_space(3)))
typedef unsigned short bf16_t;
typedef short bf16x8 __attribute__((ext_vector_type(8)));
typedef short s16x4 __attribute__((ext_vector_type(4)));
typedef float f32x4 __attribute__((ext_vector_type(4)));
typedef float f32x2 __attribute__((ext_vector_type(2)));
typedef float f32x16 __attribute__((ext_vector_type(16)));
typedef unsigned u32x4 __attribute__((ext_vector_type(4)));
typedef unsigned u32x2 __attribute__((ext_vector_type(2)));
typedef __bf16 bf16x2_t __attribute__((ext_vector_type(2)));

constexpr int NB = 8, SEQ = 2048, DM = 1024, M = NB * SEQ;
constexpr int DFF = 3072, NEXP = 8, DFE = 3584, DPLE = 256;
constexpr int NKVQ = 2048;
constexpr int QCOL = 768, GCOL = 1792;
constexpr float EPS = 1e-6f;
constexpr float LOG2E = 1.4426950408889634f;
constexpr float QSCALE = 0.125f * LOG2E;

constexpr size_t MiB = 1u << 20;
constexpr size_t WS_CTL = 0, CTL_ZERO_BYTES = 1 * MiB;
constexpr size_t WS_WIN = 1 * MiB;
constexpr size_t WS_WOUT = WS_WIN + 8 * MiB;
constexpr size_t WS_WGU = WS_WOUT + 4 * MiB;
constexpr size_t WS_WDN = WS_WGU + 24 * MiB;
constexpr size_t WS_WMGU = WS_WDN + 12 * MiB;
constexpr size_t WS_WMDN = WS_WMGU + 224 * MiB;
constexpr size_t WS_WPG = WS_WMDN + 112 * MiB;
constexpr size_t WS_WPP = WS_WPG + 8 * MiB;
constexpr size_t WS_WKVQ = WS_WPP + 2 * MiB;
constexpr size_t WS_WO = WS_WKVQ + 8 * MiB;
constexpr size_t WS_WC1 = WS_WO + 4 * MiB;
constexpr size_t WS_SMALL = WS_WC1 + 2 * MiB;
constexpr size_t WS_X = WS_SMALL + 1 * MiB;
constexpr size_t WS_XB0 = WS_X + 64 * MiB;
constexpr size_t WS_XB1 = WS_XB0 + 32 * MiB;
constexpr size_t WS_SS0 = WS_XB1 + 32 * MiB;
constexpr size_t WS_SS1 = WS_SS0 + 1 * MiB;
constexpr size_t WS_GXK = WS_SS1 + 1 * MiB;
constexpr size_t WS_YO = WS_GXK + 65 * MiB;
constexpr size_t WS_H = WS_YO + 32 * MiB;
constexpr size_t WS_XG = WS_H + 238 * MiB;
constexpr size_t WS_YM = WS_XG + 256 * MiB;
constexpr size_t WS_PP = WS_YM + 68 * MiB;
constexpr size_t WS_PB = WS_PP + 128 * MiB;
constexpr size_t WS_HID = WS_PB + 32 * MiB;
constexpr size_t WS_KC = WS_HID + 4 * MiB;
constexpr size_t WS_VTS = WS_KC + 1 * MiB;
constexpr size_t WS_VTW = WS_VTS + 4 * MiB;
constexpr size_t WS_KFS = WS_VTW + 4 * MiB;
constexpr size_t WS_KFW = WS_KFS + 4 * MiB;
constexpr size_t WS_GS = WS_KFW + 4 * MiB;
constexpr size_t WS_XQ = WS_GS + 16 * MiB;
constexpr size_t WS_ROWF = WS_XQ + 16 * MiB;
constexpr size_t WS_RT = WS_ROWF + 1 * MiB;
constexpr size_t WS_END = WS_RT + 2 * MiB;
constexpr int CW_BAR = 4096;
constexpr int CW_CNT = 16384;
constexpr int CW_WMAX = 20480;

constexpr int RING_OFF = 0, RING_BYTES = 131072;
constexpr int LDSCTL_OFF = RING_BYTES, MISC_OFF = LDSCTL_OFF + 320;
constexpr int LDS_BYTES = 147456;
constexpr int NWAVES = 8;

#define LDS_WAIT() asm volatile("s_waitcnt lgkmcnt(0)" ::: "memory")
#define VM_WAIT() asm volatile("s_waitcnt vmcnt(0)" ::: "memory")

__device__ __forceinline__ unsigned f2bf(float f) { unsigned u = __builtin_bit_cast(unsigned, f); return (u + 0x7fffu + ((u >> 16) & 1u)) >> 16; }
__device__ __forceinline__ unsigned pk2(float lo, float hi) { f32x2 v = {lo, hi}; bf16x2_t b = __builtin_convertvector(v, bf16x2_t); return __builtin_bit_cast(unsigned, b); }
__device__ __forceinline__ float bflo(unsigned w) { return __builtin_bit_cast(float, w << 16); }
__device__ __forceinline__ float bfhi(unsigned w) { return __builtin_bit_cast(float, w & 0xffff0000u); }
__device__ __forceinline__ float bf1(bf16_t h) { return __builtin_bit_cast(float, (unsigned)h << 16); }
__device__ __forceinline__ float ex2(float x) { return __builtin_amdgcn_exp2f(x); }
__device__ __forceinline__ float rcpf_(float x) { return __builtin_amdgcn_rcpf(x); }
__device__ __forceinline__ float sigmoidf_(float x) { return rcpf_(1.0f + ex2(-x * LOG2E)); }
__device__ __forceinline__ float gelu_tanh(float v) { const float z = v * (1.5957691216057308f + 0.07135481627260025f * v * v); return v * rcpf_(1.0f + ex2(-z * LOG2E)); }
__device__ __forceinline__ float silu_(float v) { return v * rcpf_(1.0f + ex2(-v * LOG2E)); }
__device__ __forceinline__ int opaque_v(int x) { asm volatile("" : "+v"(x)); return x; }
__device__ __forceinline__ int opaque_s(int x) { asm volatile("" : "+s"(x)); return x; }
__device__ __forceinline__ int lane_id() { return (int)__builtin_amdgcn_mbcnt_hi(~0u, __builtin_amdgcn_mbcnt_lo(~0u, 0u)); }
__device__ __forceinline__ int lane_id_fresh() { int x; asm volatile("v_mbcnt_lo_u32_b32 %0, -1, 0\n\tv_mbcnt_hi_u32_b32 %0, -1, %0" : "=v"(x)); return x; }
#define DPP_F(v, ctrl, rmask) __builtin_bit_cast(float, __builtin_amdgcn_update_dpp(0, __builtin_bit_cast(int, v), ctrl, rmask, 0xF, false))
__device__ __forceinline__ float wave_sum(float v) {
    v += DPP_F(v, 0xB1, 0xF); v += DPP_F(v, 0x4E, 0xF); v += DPP_F(v, 0x141, 0xF); v += DPP_F(v, 0x140, 0xF);
    v += DPP_F(v, 0x142, 0xA); v += DPP_F(v, 0x143, 0xC);
    return __builtin_bit_cast(float, __builtin_amdgcn_readlane(__builtin_bit_cast(int, v), 63));
}
__device__ __forceinline__ float wave_max_nonneg(float v) {
    v = fmaxf(v, DPP_F(v, 0xB1, 0xF)); v = fmaxf(v, DPP_F(v, 0x4E, 0xF)); v = fmaxf(v, DPP_F(v, 0x141, 0xF)); v = fmaxf(v, DPP_F(v, 0x140, 0xF));
    v = fmaxf(v, DPP_F(v, 0x142, 0xA)); v = fmaxf(v, DPP_F(v, 0x143, 0xC));
    return __builtin_bit_cast(float, __builtin_amdgcn_readlane(__builtin_bit_cast(int, v), 63));
}

namespace pg8 {
constexpr int BM = 256, BK = 64, HALF = 128, HTB = HALF * BK * 2, STAGE_BYTES = 8 * HTB;
__host__ __device__ __forceinline__ int lds_byte(int r, int c) { const int st = (r >> 4) * 2 + (c >> 5), rr = r & 15, cc = c & 31, ob = rr * 64 + cc * 2; return st * 1024 + (ob ^ (((ob >> 9) & 1) << 5)); }
__host__ __device__ __forceinline__ void stage_rc(int b, int& R, int& C) { const int st = b / 1024, sb = b % 1024, swz = sb ^ (((sb >> 9) & 1) << 5); R = (st >> 1) * 16 + swz / 64; C = (st & 1) * 32 + (swz % 64) / 2; }
__host__ __device__ __forceinline__ int perm32(int rho) { const int n = rho >> 4, i = rho & 15; return 8 * (i >> 2) + 4 * n + (i & 3); }

struct Unit { const char* a; const char* b; int orow, ocol, pn, aux; };
struct Geo { int K; unsigned lda, ldb, kstA, kstB; size_t hstA, hstB; };

typedef int v4i __attribute__((ext_vector_type(4)));
template <class Epi, class Sched>
__device__ __forceinline__ void gemm_phase(LAS unsigned char* lds, const Geo g, const Sched& S, const Epi& E, int wv) {
    const int wid = opaque_s(wv), lane = opaque_v(lane_id()), tid = wid * 64 + lane, wr = wid >> 2, wc = wid & 3, fr = lane & 15, fq = lane >> 4;
    const int K = opaque_s(g.K), nt = K / BK;
    unsigned voffA[2], voffB[2];
#pragma unroll
    for (int i = 0; i < 2; ++i) { int R, C; stage_rc(tid * 16 + i * 8192, R, C); const int Rb = (R & ~31) + perm32(R & 31);
        voffA[i] = (unsigned)R * g.lda + (unsigned)C * 2u; voffB[i] = (unsigned)Rb * g.ldb + (unsigned)C * 2u; }
    const size_t kstA = g.kstA, kstB = g.kstB, hstA = g.hstA, hstB = g.hstB;
    const unsigned ldsw = (unsigned)wid * 1024u;
    const int aoff = lds_byte(wr * 64 + fr, fq * 8), boff = lds_byte(wc * 32 + fr, fq * 8);
#define PG8_SA(b, h) (((b) * 2 + (h)) * HTB)
#define PG8_SB(b, h) ((4 + (b) * 2 + (h)) * HTB)
#define PG8_STAGE(bufoff, gbase, voff) do { _Pragma("unroll") for (int _i = 0; _i < 2; ++_i) \
        __builtin_amdgcn_global_load_lds((const unsigned*)((const char*)(gbase) + (voff)[_i]), (LAS unsigned*)(lds + (bufoff) + ldsw + _i * 8192), 16, 0, 0); } while (0)
#define PG8_LDA(dst, b, h) do { _Pragma("unroll") for (int m = 0; m < 4; ++m) _Pragma("unroll") for (int k = 0; k < 2; ++k) dst[m][k] = *(const LAS bf16x8*)(lds + PG8_SA(b, h) + aoff + m * 2048 + k * 1024); } while (0)
#define PG8_LDB(dst, b, h) do { _Pragma("unroll") for (int n = 0; n < 2; ++n) _Pragma("unroll") for (int k = 0; k < 2; ++k) dst[n][k] = *(const LAS bf16x8*)(lds + PG8_SB(b, h) + boff + n * 2048 + k * 1024); } while (0)
#define PG8_MMA(ai, bj, At, Bt) do { __builtin_amdgcn_s_setprio(1); _Pragma("unroll") for (int m = 0; m < 4; ++m) _Pragma("unroll") for (int n = 0; n < 2; ++n) _Pragma("unroll") for (int k = 0; k < 2; ++k) \
        acc[ai][bj][m][n] = __builtin_amdgcn_mfma_f32_16x16x32_bf16(Bt[n][k], At[m][k], acc[ai][bj][m][n], 0, 0, 0); __builtin_amdgcn_s_setprio(0); } while (0)
#define PG8_WAIT_V(n) asm volatile("s_waitcnt vmcnt(" #n ")" ::: "memory")
#define PG8_WAIT_L(n) asm volatile("s_waitcnt lgkmcnt(" #n ")" ::: "memory")
#define PG8_BAR __builtin_amdgcn_s_barrier()
#define PG8_SCHED __builtin_amdgcn_sched_barrier(0)
    Unit cur, nxt; int ui = 0;
    if (!S.next(0, cur)) return;
    f32x4 acc[2][2][4][2];
#pragma unroll
    for (int a = 0; a < 2; ++a)
#pragma unroll
        for (int b = 0; b < 2; ++b)
#pragma unroll
            for (int m = 0; m < 4; ++m)
#pragma unroll
                for (int n = 0; n < 2; ++n) acc[a][b][m][n] = (f32x4){0.f, 0.f, 0.f, 0.f};
    bf16x8 At[4][2], B0[2][2], B1[2][2];
    const char* cA = cur.a; const char* cB = cur.b;
    PG8_STAGE(PG8_SB(0, 0), cB, voffB); PG8_STAGE(PG8_SB(0, 1), cB + hstB, voffB); PG8_STAGE(PG8_SA(0, 0), cA, voffA); PG8_STAGE(PG8_SA(0, 1), cA + hstA, voffA);
    if (wr == 1) PG8_BAR;
    PG8_WAIT_V(2); PG8_BAR;
    PG8_STAGE(PG8_SB(1, 0), cB + kstB, voffB); PG8_STAGE(PG8_SA(1, 0), cA + kstA, voffA); PG8_STAGE(PG8_SB(1, 1), cB + hstB + kstB, voffB);
    PG8_WAIT_V(6); PG8_BAR;
    for (;;) {
        const bool has_next = S.next(ui + 1, nxt);
        const char* nA = has_next ? nxt.a : cA; const char* nB = has_next ? nxt.b : cB;
        for (int t = 0; t < nt; t += 2) {
            const bool last = (t == nt - 2);
            const char* a1 = cA + (size_t)(t + 1) * kstA;
            const char* a2 = last ? nA : cA + (size_t)(t + 2) * kstA; const char* b2 = last ? nB : cB + (size_t)(t + 2) * kstB;
            const char* a3 = a2 + kstA; const char* b3 = b2 + kstB;
            PG8_LDB(B0, 0, 0); PG8_LDB(B1, 0, 1); PG8_SCHED; PG8_LDA(At, 0, 0); PG8_STAGE(PG8_SA(1, 1), a1 + hstA, voffA);
            PG8_WAIT_V(8); PG8_WAIT_L(0); PG8_BAR; PG8_MMA(0, 0, At, B0); PG8_MMA(0, 1, At, B1); PG8_BAR; PG8_SCHED;
            PG8_LDA(At, 0, 1); PG8_STAGE(PG8_SB(0, 0), b2, voffB); PG8_STAGE(PG8_SB(0, 1), b2 + hstB, voffB); PG8_STAGE(PG8_SA(0, 0), a2, voffA);
            PG8_WAIT_V(8); PG8_WAIT_L(0); PG8_BAR; PG8_MMA(1, 0, At, B0); PG8_MMA(1, 1, At, B1); PG8_BAR; PG8_SCHED;
            PG8_LDB(B0, 1, 0); PG8_LDB(B1, 1, 1); PG8_SCHED; PG8_LDA(At, 1, 0); PG8_STAGE(PG8_SA(0, 1), a2 + hstA, voffA);
            PG8_WAIT_V(8); PG8_WAIT_L(0); PG8_BAR; PG8_MMA(0, 0, At, B0); PG8_MMA(0, 1, At, B1); PG8_BAR; PG8_SCHED;
            PG8_LDA(At, 1, 1); PG8_STAGE(PG8_SB(1, 0), b3, voffB); PG8_STAGE(PG8_SB(1, 1), b3 + hstB, voffB); PG8_STAGE(PG8_SA(1, 0), a3, voffA);
            PG8_WAIT_V(8); PG8_WAIT_L(0); PG8_BAR; PG8_MMA(1, 0, At, B0); PG8_MMA(1, 1, At, B1); PG8_BAR; PG8_SCHED;
        }
        if (wr == 0) PG8_BAR;
        E(acc, cur, wr, wc, fr, fq);
        if (!has_next) break;
#pragma unroll
        for (int a = 0; a < 2; ++a)
#pragma unroll
            for (int b = 0; b < 2; ++b)
#pragma unroll
                for (int m = 0; m < 4; ++m)
#pragma unroll
                    for (int n = 0; n < 2; ++n) acc[a][b][m][n] = (f32x4){0.f, 0.f, 0.f, 0.f};
        cur = nxt; cA = nA; cB = nB; ++ui;
        if (wr == 1) PG8_BAR;
    }
    PG8_WAIT_V(0);
    PG8_BAR;
#undef PG8_SA
#undef PG8_SB
#undef PG8_STAGE
#undef PG8_LDA
#undef PG8_LDB
#undef PG8_MMA
#undef PG8_WAIT_V
#undef PG8_WAIT_L
#undef PG8_BAR
#undef PG8_SCHED
}

template <class Epi, class Sched>
__device__ __forceinline__ void gemm_phase_i8(LAS unsigned char* lds, const Geo g, const Sched& S, const Epi& E, int wv) {
    const int wid = opaque_s(wv), lane = opaque_v(lane_id()), tid = wid * 64 + lane, wr = wid >> 2, wc = wid & 3, fr = lane & 15, fq = lane >> 4;
    const int K = opaque_s(g.K), nt = K / 128;
    unsigned voffA[2], voffB[2];
#pragma unroll
    for (int i = 0; i < 2; ++i) { int R, C; stage_rc(tid * 16 + i * 8192, R, C); const int Rb = (R & ~31) + perm32(R & 31);
        voffA[i] = (unsigned)R * g.lda + (unsigned)C * 2u; voffB[i] = (unsigned)Rb * g.ldb + (unsigned)C * 2u; }
    const size_t kstA = g.kstA, kstB = g.kstB, hstA = g.hstA, hstB = g.hstB;
    const unsigned ldsw = (unsigned)wid * 1024u;
    const int aoff = lds_byte(wr * 64 + fr, fq * 8), boff = lds_byte(wc * 32 + fr, fq * 8);
#define PG8_SA(b, h) (((b) * 2 + (h)) * HTB)
#define PG8_SB(b, h) ((4 + (b) * 2 + (h)) * HTB)
#define PG8_STAGE(bufoff, gbase, voff) do { _Pragma("unroll") for (int _i = 0; _i < 2; ++_i) \
        __builtin_amdgcn_global_load_lds((const unsigned*)((const char*)(gbase) + (voff)[_i]), (LAS unsigned*)(lds + (bufoff) + ldsw + _i * 8192), 16, 0, 0); } while (0)
#define PG8_LDA(dst, b, h) do { _Pragma("unroll") for (int m = 0; m < 4; ++m) _Pragma("unroll") for (int k = 0; k < 2; ++k) dst[m][k] = *(const LAS bf16x8*)(lds + PG8_SA(b, h) + aoff + m * 2048 + k * 1024); } while (0)
#define PG8_LDB(dst, b, h) do { _Pragma("unroll") for (int n = 0; n < 2; ++n) _Pragma("unroll") for (int k = 0; k < 2; ++k) dst[n][k] = *(const LAS bf16x8*)(lds + PG8_SB(b, h) + boff + n * 2048 + k * 1024); } while (0)
#define PG8_MMA(ai, bj, At, Bt) do { __builtin_amdgcn_s_setprio(1); _Pragma("unroll") for (int m = 0; m < 4; ++m) _Pragma("unroll") for (int n = 0; n < 2; ++n) _Pragma("unroll") for (int k = 0; k < 2; ++k) \
        acc[ai][bj][m][n] = __builtin_amdgcn_mfma_i32_16x16x64_i8(__builtin_bit_cast(v4i, Bt[n][k]), __builtin_bit_cast(v4i, At[m][k]), acc[ai][bj][m][n], 0, 0, 0); __builtin_amdgcn_s_setprio(0); } while (0)
#define PG8_WAIT_V(n) asm volatile("s_waitcnt vmcnt(" #n ")" ::: "memory")
#define PG8_WAIT_L(n) asm volatile("s_waitcnt lgkmcnt(" #n ")" ::: "memory")
#define PG8_BAR __builtin_amdgcn_s_barrier()
#define PG8_SCHED __builtin_amdgcn_sched_barrier(0)
    Unit cur, nxt; int ui = 0;
    if (!S.next(0, cur)) return;
    v4i acc[2][2][4][2];
#pragma unroll
    for (int a = 0; a < 2; ++a)
#pragma unroll
        for (int b = 0; b < 2; ++b)
#pragma unroll
            for (int m = 0; m < 4; ++m)
#pragma unroll
                for (int n = 0; n < 2; ++n) acc[a][b][m][n] = (v4i){0, 0, 0, 0};
    bf16x8 At[4][2], B0[2][2], B1[2][2];
    const char* cA = cur.a; const char* cB = cur.b;
    PG8_STAGE(PG8_SB(0, 0), cB, voffB); PG8_STAGE(PG8_SB(0, 1), cB + hstB, voffB); PG8_STAGE(PG8_SA(0, 0), cA, voffA); PG8_STAGE(PG8_SA(0, 1), cA + hstA, voffA);
    if (wr == 1) PG8_BAR;
    PG8_WAIT_V(2); PG8_BAR;
    PG8_STAGE(PG8_SB(1, 0), cB + kstB, voffB); PG8_STAGE(PG8_SA(1, 0), cA + kstA, voffA); PG8_STAGE(PG8_SB(1, 1), cB + hstB + kstB, voffB);
    PG8_WAIT_V(6); PG8_BAR;
    for (;;) {
        const bool has_next = S.next(ui + 1, nxt);
        const char* nA = has_next ? nxt.a : cA; const char* nB = has_next ? nxt.b : cB;
        for (int t = 0; t < nt; t += 2) {
            const bool last = (t == nt - 2);
            const char* a1 = cA + (size_t)(t + 1) * kstA;
            const char* a2 = last ? nA : cA + (size_t)(t + 2) * kstA; const char* b2 = last ? nB : cB + (size_t)(t + 2) * kstB;
            const char* a3 = a2 + kstA; const char* b3 = b2 + kstB;
            PG8_LDB(B0, 0, 0); PG8_LDB(B1, 0, 1); PG8_SCHED; PG8_LDA(At, 0, 0); PG8_STAGE(PG8_SA(1, 1), a1 + hstA, voffA);
            PG8_WAIT_V(8); PG8_WAIT_L(0); PG8_BAR; PG8_MMA(0, 0, At, B0); PG8_MMA(0, 1, At, B1); PG8_BAR; PG8_SCHED;
            PG8_LDA(At, 0, 1); PG8_STAGE(PG8_SB(0, 0), b2, voffB); PG8_STAGE(PG8_SB(0, 1), b2 + hstB, voffB); PG8_STAGE(PG8_SA(0, 0), a2, voffA);
            PG8_WAIT_V(8); PG8_WAIT_L(0); PG8_BAR; PG8_MMA(1, 0, At, B0); PG8_MMA(1, 1, At, B1); PG8_BAR; PG8_SCHED;
            PG8_LDB(B0, 1, 0); PG8_LDB(B1, 1, 1); PG8_SCHED; PG8_LDA(At, 1, 0); PG8_STAGE(PG8_SA(0, 1), a2 + hstA, voffA);
            PG8_WAIT_V(8); PG8_WAIT_L(0); PG8_BAR; PG8_MMA(0, 0, At, B0); PG8_MMA(0, 1, At, B1); PG8_BAR; PG8_SCHED;
            PG8_LDA(At, 1, 1); PG8_STAGE(PG8_SB(1, 0), b3, voffB); PG8_STAGE(PG8_SB(1, 1), b3 + hstB, voffB); PG8_STAGE(PG8_SA(1, 0), a3, voffA);
            PG8_WAIT_V(8); PG8_WAIT_L(0); PG8_BAR; PG8_MMA(1, 0, At, B0); PG8_MMA(1, 1, At, B1); PG8_BAR; PG8_SCHED;
        }
        if (wr == 0) PG8_BAR;
        E(acc, cur, wr, wc, fr, fq);
        if (!has_next) break;
#pragma unroll
        for (int a = 0; a < 2; ++a)
#pragma unroll
            for (int b = 0; b < 2; ++b)
#pragma unroll
                for (int m = 0; m < 4; ++m)
#pragma unroll
                    for (int n = 0; n < 2; ++n) acc[a][b][m][n] = (v4i){0, 0, 0, 0};
        cur = nxt; cA = nA; cB = nB; ++ui;
        if (wr == 1) PG8_BAR;
    }
    PG8_WAIT_V(0);
    PG8_BAR;
#undef PG8_SA
#undef PG8_SB
#undef PG8_STAGE
#undef PG8_LDA
#undef PG8_LDB
#undef PG8_MMA
#undef PG8_WAIT_V
#undef PG8_WAIT_L
#undef PG8_BAR
#undef PG8_SCHED
}

typedef int v8i __attribute__((ext_vector_type(8)));
template <class Epi, class Sched>
__device__ __forceinline__ void gemm_phase_f8(LAS unsigned char* lds, const Geo g, const Sched& S, const Epi& E, int wv) {
    const int wid = opaque_s(wv), lane = opaque_v(lane_id()), tid = wid * 64 + lane, wr = wid >> 2, wc = wid & 3, fr = lane & 15, fq = lane >> 4;
    const int K = opaque_s(g.K), nt = K / 128;
    unsigned voffA[2], voffB[2];
#pragma unroll
    for (int i = 0; i < 2; ++i) { int R, C; stage_rc(tid * 16 + i * 8192, R, C); const int Rb = (R & ~31) + perm32(R & 31);
        voffA[i] = (unsigned)R * g.lda + (unsigned)C * 2u; voffB[i] = (unsigned)Rb * g.ldb + (unsigned)C * 2u; }
    const size_t kstA = g.kstA, kstB = g.kstB, hstA = g.hstA, hstB = g.hstB;
    const unsigned ldsw = (unsigned)wid * 1024u;
    const int aoff = lds_byte(wr * 64 + fr, fq * 8), boff = lds_byte(wc * 32 + fr, fq * 8);
#define PG8_SA(b, h) (((b) * 2 + (h)) * HTB)
#define PG8_SB(b, h) ((4 + (b) * 2 + (h)) * HTB)
#define PG8_STAGE(bufoff, gbase, voff) do { _Pragma("unroll") for (int _i = 0; _i < 2; ++_i) \
        __builtin_amdgcn_global_load_lds((const unsigned*)((const char*)(gbase) + (voff)[_i]), (LAS unsigned*)(lds + (bufoff) + ldsw + _i * 8192), 16, 0, 0); } while (0)
#define PG8_LD8(p) __builtin_shufflevector(*(const LAS v4i*)(p), *(const LAS v4i*)((p) + 1024), 0, 1, 2, 3, 4, 5, 6, 7)
#define PG8_LDA(dst, b, h) do { _Pragma("unroll") for (int m = 0; m < 4; ++m) dst[m] = PG8_LD8(lds + PG8_SA(b, h) + aoff + m * 2048); } while (0)
#define PG8_LDB(dst, b, h) do { _Pragma("unroll") for (int n = 0; n < 2; ++n) dst[n] = PG8_LD8(lds + PG8_SB(b, h) + boff + n * 2048); } while (0)
#define PG8_MMA(ai, bj, At, Bt) do { __builtin_amdgcn_s_setprio(1); _Pragma("unroll") for (int m = 0; m < 4; ++m) _Pragma("unroll") for (int n = 0; n < 2; ++n) \
        asm volatile("v_mfma_f32_16x16x128_f8f6f4 %0, %1, %2, %0" : "+v"(acc[ai][bj][m][n]) : "v"(Bt[n]), "v"(At[m])); __builtin_amdgcn_s_setprio(0); } while (0)
#define PG8_WAIT_V(n) asm volatile("s_waitcnt vmcnt(" #n ")" ::: "memory")
#define PG8_WAIT_L(n) asm volatile("s_waitcnt lgkmcnt(" #n ")" ::: "memory")
#define PG8_BAR __builtin_amdgcn_s_barrier()
#define PG8_SCHED __builtin_amdgcn_sched_barrier(0)
    Unit cur, nxt; int ui = 0;
    if (!S.next(0, cur)) return;
    f32x4 acc[2][2][4][2];
#pragma unroll
    for (int a = 0; a < 2; ++a)
#pragma unroll
        for (int b = 0; b < 2; ++b)
#pragma unroll
            for (int m = 0; m < 4; ++m)
#pragma unroll
                for (int n = 0; n < 2; ++n) acc[a][b][m][n] = (f32x4){0.f, 0.f, 0.f, 0.f};
    v8i At[4], B0[2], B1[2];
    const char* cA = cur.a; const char* cB = cur.b;
    PG8_STAGE(PG8_SB(0, 0), cB, voffB); PG8_STAGE(PG8_SB(0, 1), cB + hstB, voffB); PG8_STAGE(PG8_SA(0, 0), cA, voffA); PG8_STAGE(PG8_SA(0, 1), cA + hstA, voffA);
    if (wr == 1) PG8_BAR;
    PG8_WAIT_V(2); PG8_BAR;
    PG8_STAGE(PG8_SB(1, 0), cB + kstB, voffB); PG8_STAGE(PG8_SA(1, 0), cA + kstA, voffA); PG8_STAGE(PG8_SB(1, 1), cB + hstB + kstB, voffB);
    PG8_WAIT_V(6); PG8_BAR;
    for (;;) {
        const bool has_next = S.next(ui + 1, nxt);
        const char* nA = has_next ? nxt.a : cA; const char* nB = has_next ? nxt.b : cB;
        for (int t = 0; t < nt; t += 2) {
            const bool last = (t == nt - 2);
            const char* a1 = cA + (size_t)(t + 1) * kstA;
            const char* a2 = last ? nA : cA + (size_t)(t + 2) * kstA; const char* b2 = last ? nB : cB + (size_t)(t + 2) * kstB;
            const char* a3 = a2 + kstA; const char* b3 = b2 + kstB;
            PG8_LDB(B0, 0, 0); PG8_LDB(B1, 0, 1); PG8_SCHED; PG8_LDA(At, 0, 0); PG8_STAGE(PG8_SA(1, 1), a1 + hstA, voffA);
            PG8_WAIT_V(8); PG8_WAIT_L(0); PG8_BAR; PG8_MMA(0, 0, At, B0); PG8_MMA(0, 1, At, B1); PG8_BAR; PG8_SCHED;
            PG8_LDA(At, 0, 1); PG8_STAGE(PG8_SB(0, 0), b2, voffB); PG8_STAGE(PG8_SB(0, 1), b2 + hstB, voffB); PG8_STAGE(PG8_SA(0, 0), a2, voffA);
            PG8_WAIT_V(8); PG8_WAIT_L(0); PG8_BAR; PG8_MMA(1, 0, At, B0); PG8_MMA(1, 1, At, B1); PG8_BAR; PG8_SCHED;
            PG8_LDB(B0, 1, 0); PG8_LDB(B1, 1, 1); PG8_SCHED; PG8_LDA(At, 1, 0); PG8_STAGE(PG8_SA(0, 1), a2 + hstA, voffA);
            PG8_WAIT_V(8); PG8_WAIT_L(0); PG8_BAR; PG8_MMA(0, 0, At, B0); PG8_MMA(0, 1, At, B1); PG8_BAR; PG8_SCHED;
            PG8_LDA(At, 1, 1); PG8_STAGE(PG8_SB(1, 0), b3, voffB); PG8_STAGE(PG8_SB(1, 1), b3 + hstB, voffB); PG8_STAGE(PG8_SA(1, 0), a3, voffA);
            PG8_WAIT_V(8); PG8_WAIT_L(0); PG8_BAR; PG8_MMA(1, 0, At, B0); PG8_MMA(1, 1, At, B1); PG8_BAR; PG8_SCHED;
        }
        if (wr == 0) PG8_BAR;
        asm volatile("s_nop 15\n\ts_nop 15" ::: "memory");
        E(acc, cur, wr, wc, fr, fq);
        if (DUP(30)) { asm volatile("" ::: "memory"); E(acc, cur, wr, wc, fr, fq); }
        if (!has_next) break;
#pragma unroll
        for (int a = 0; a < 2; ++a)
#pragma unroll
            for (int b = 0; b < 2; ++b)
#pragma unroll
                for (int m = 0; m < 4; ++m)
#pragma unroll
                    for (int n = 0; n < 2; ++n) acc[a][b][m][n] = (f32x4){0.f, 0.f, 0.f, 0.f};
        cur = nxt; cA = nA; cB = nB; ++ui;
        if (wr == 1) PG8_BAR;
    }
    PG8_WAIT_V(0);
    PG8_BAR;
#undef PG8_SA
#undef PG8_SB
#undef PG8_STAGE
#undef PG8_LDA
#undef PG8_LDB
#undef PG8_MMA
#undef PG8_LD8
#undef PG8_WAIT_V
#undef PG8_WAIT_L
#undef PG8_BAR
#undef PG8_SCHED
}

__device__ __forceinline__ float row_rstd(const float* ss, int row, int fq) {
    const f32x4 v = *(const f32x4*)(ss + (size_t)row * 16 + fq * 4);
    float s = (v[0] + v[1]) + (v[2] + v[3]);
    s += __shfl_xor(s, 16); s += __shfl_xor(s, 32);
    return __builtin_amdgcn_rsqf(s * (1.0f / 1024.0f) + EPS);
}
struct EpiAct {
    bf16_t* O; int ldc; const float* ss; float osc;
    __device__ __forceinline__ void operator()(const f32x4 (&acc)[2][2][4][2], const Unit& u, int wr, int wc, int fr, int fq) const {
        const bool gl = (u.aux & 1) != 0; const float sc = (u.aux & 2) ? QSCALE : 1.0f;
#pragma unroll
        for (int ai = 0; ai < 2; ++ai)
#pragma unroll
            for (int m = 0; m < 4; ++m) {
                const int row = u.orow + ai * HALF + wr * 64 + m * 16 + fr;
                const float rs = (ss ? row_rstd(ss, row, fq) : 1.0f) * sc * osc;
                bf16_t* rowp = O + (size_t)row * ldc + u.ocol + wc * 32 + 8 * fq;
#pragma unroll
                for (int bj = 0; bj < 2; ++bj) { f32x4 v0 = acc[ai][bj][m][0] * rs, v1 = acc[ai][bj][m][1] * rs;
                    if (gl) {
#pragma unroll
                        for (int e = 0; e < 4; ++e) { v0[e] = gelu_tanh(v0[e]); v1[e] = gelu_tanh(v1[e]); } }
                    u32x4 w; w.x = pk2(v0[0], v0[1]); w.y = pk2(v0[2], v0[3]); w.z = pk2(v1[0], v1[1]); w.w = pk2(v1[2], v1[3]);
                    *(u32x4*)(rowp + bj * HALF) = w; } }
    }
};
struct EpiCmp {
    float* O;
    __device__ __forceinline__ void operator()(const f32x4 (&acc)[2][2][4][2], const Unit& u, int wr, int wc, int fr, int fq) const {
        float* OO = O + (size_t)u.aux * 2048 * 256;
#pragma unroll
        for (int bj = 0; bj < 2; ++bj) { const int col = bj * HALF + wc * 32 + 8 * fq;
#pragma unroll
            for (int ai = 0; ai < 2; ++ai)
#pragma unroll
                for (int m = 0; m < 4; ++m) { const int row = u.orow + ai * HALF + wr * 64 + m * 16 + fr;
                    *(f32x4*)(OO + (size_t)row * 256 + col) = acc[ai][bj][m][0]; *(f32x4*)(OO + (size_t)row * 256 + col + 4) = acc[ai][bj][m][1]; } }
    }
};
struct EpiGateSlab {
    float* O; const float* ss;
    __device__ __forceinline__ void operator()(const f32x4 (&acc)[2][2][4][2], const Unit& u, int wr, int wc, int fr, int fq) const {
        if (wc >= 2) return;
        float* OO = O + (size_t)u.aux * M * 64;
#pragma unroll
        for (int ai = 0; ai < 2; ++ai)
#pragma unroll
            for (int m = 0; m < 4; ++m) { const int row = u.orow + ai * HALF + wr * 64 + m * 16 + fr; const float rs = row_rstd(ss, row, fq);
                *(f32x4*)(OO + (size_t)row * 64 + wc * 32 + 8 * fq) = acc[ai][0][m][0] * rs; *(f32x4*)(OO + (size_t)row * 64 + wc * 32 + 8 * fq + 4) = acc[ai][0][m][1] * rs; }
    }
};
struct GateOrder {
    const char* A; const char* Bt; int G, c;
    __device__ __forceinline__ bool next(int i, Unit& u) const {
        const int L = i * G + c; if (L >= 256) return false;
        const int pm = L & 63, ks = L >> 6;
        u.a = A + (size_t)pm * 256 * 2048 + ks * 512; u.b = Bt + ks * 512; u.orow = pm * 256; u.ocol = 0; u.pn = 0; u.aux = ks; return true;
    }
};
template <int MOE> struct EpiGated {
    bf16_t* O; int ldc; const float* ss; const float* rsA; const float* rsC;
    __device__ __forceinline__ void operator()(const f32x4 (&acc)[2][2][4][2], const Unit& u, int wr, int wc, int fr, int fq) const {
#pragma unroll
        for (int ai = 0; ai < 2; ++ai)
#pragma unroll
            for (int m = 0; m < 4; ++m) {
                const int lrow = ai * HALF + wr * 64 + m * 16 + fr, row = u.orow + lrow;
                float ra, rc;
                if (MOE) { ra = 0.015625f; rc = 1.0f; } else { ra = row_rstd(ss, row, fq); rc = 1.0f; }
                const f32x4 g0 = acc[ai][0][m][0] * ra, g1 = acc[ai][0][m][1] * ra, u0 = acc[ai][1][m][0] * (ra * rc), u1 = acc[ai][1][m][1] * (ra * rc);
                float h[8];
#pragma unroll
                for (int e = 0; e < 4; ++e) { h[e] = silu_(g0[e]) * u0[e]; h[4 + e] = silu_(g1[e]) * u1[e];
                    if (MOE) { h[e] = fminf(fmaxf(h[e], -448.f), 448.f); h[4 + e] = fminf(fmaxf(h[4 + e], -448.f), 448.f); } }
                if (MOE) { u32x2 w8; int t0 = __builtin_amdgcn_cvt_pk_fp8_f32(h[0], h[1], 0, false); t0 = __builtin_amdgcn_cvt_pk_fp8_f32(h[2], h[3], t0, true);
                    int t1 = __builtin_amdgcn_cvt_pk_fp8_f32(h[4], h[5], 0, false); t1 = __builtin_amdgcn_cvt_pk_fp8_f32(h[6], h[7], t1, true); w8.x = (unsigned)t0; w8.y = (unsigned)t1;
                    *(u32x2*)((unsigned char*)O + (size_t)row * ldc + u.ocol + wc * 32 + 8 * fq) = w8; }
                else { u32x4 w; w.x = pk2(h[0], h[1]); w.y = pk2(h[2], h[3]); w.z = pk2(h[4], h[5]); w.w = pk2(h[6], h[7]);
                    *(u32x4*)(O + (size_t)row * ldc + u.ocol + wc * 32 + 8 * fq) = w; } }
    }
};
struct EpiGatedI8 {
    bf16_t* O; int ldc; const float* rowf; float wsc;
    __device__ __forceinline__ void operator()(const v4i (&acc)[2][2][4][2], const Unit& u, int wr, int wc, int fr, int fq) const {
#pragma unroll
        for (int ai = 0; ai < 2; ++ai)
#pragma unroll
            for (int m = 0; m < 4; ++m) {
                const int row = u.orow + ai * HALF + wr * 64 + m * 16 + fr;
                const float rf = rowf[row] * wsc;
                float h[8];
#pragma unroll
                for (int e = 0; e < 4; ++e) { h[e] = silu_((float)acc[ai][0][m][0][e] * rf) * ((float)acc[ai][1][m][0][e] * rf); h[4 + e] = silu_((float)acc[ai][0][m][1][e] * rf) * ((float)acc[ai][1][m][1][e] * rf); }
                u32x4 w; w.x = pk2(h[0], h[1]); w.y = pk2(h[2], h[3]); w.z = pk2(h[4], h[5]); w.w = pk2(h[6], h[7]);
                *(u32x4*)(O + (size_t)row * ldc + u.ocol + wc * 32 + 8 * fq) = w; }
    }
};
template <int GATE> struct EpiResid {
    const float* x32; const bf16_t* xb_in; bf16_t* xb; float* ssn; const float* ss; const bf16_t* pp;
    __device__ __forceinline__ void operator()(const f32x4 (&acc)[2][2][4][2], const Unit& u, int wr, int wc, int fr, int fq) const {
#pragma unroll
        for (int ai = 0; ai < 2; ++ai)
#pragma unroll
            for (int m = 0; m < 4; ++m) {
                const int row = u.orow + ai * HALF + wr * 64 + m * 16 + fr;
                float rs = 1.0f; if (GATE) rs = row_rstd(ss, row, fq);
                float sq = 0.f;
#pragma unroll
                for (int bj = 0; bj < 2; ++bj) { const size_t off = (size_t)row * DM + u.ocol + bj * HALF + wc * 32 + 8 * fq;
                    f32x4 x0, x1;
                    if (x32) { x0 = *(const f32x4*)(x32 + off); x1 = *(const f32x4*)(x32 + off + 4); }
                    else { const u32x4 xw = *(const u32x4*)(xb_in + off); x0 = (f32x4){bflo(xw.x), bfhi(xw.x), bflo(xw.y), bfhi(xw.y)}; x1 = (f32x4){bflo(xw.z), bfhi(xw.z), bflo(xw.w), bfhi(xw.w)}; }
                    f32x4 v0 = acc[ai][bj][m][0], v1 = acc[ai][bj][m][1];
                    if (GATE) { const u32x4 pw = *(const u32x4*)(pp + off);
                        const f32x4 p0 = {bflo(pw.x), bfhi(pw.x), bflo(pw.y), bfhi(pw.y)}, p1 = {bflo(pw.z), bfhi(pw.z), bflo(pw.w), bfhi(pw.w)};
#pragma unroll
                        for (int e = 0; e < 4; ++e) { v0[e] = sigmoidf_(v0[e] * rs) * p0[e]; v1[e] = sigmoidf_(v1[e] * rs) * p1[e]; } }
                    x0 += v0; x1 += v1;
                    u32x4 w; w.x = pk2(x0[0], x0[1]); w.y = pk2(x0[2], x0[3]); w.z = pk2(x1[0], x1[1]); w.w = pk2(x1[2], x1[3]);
                    *(u32x4*)(xb + off) = w;
                    sq += ((x0[0] * x0[0] + x0[1] * x0[1]) + (x0[2] * x0[2] + x0[3] * x0[3])) + ((x1[0] * x1[0] + x1[1] * x1[1]) + (x1[2] * x1[2] + x1[3] * x1[3])); }
                sq += __shfl_xor(sq, 16); sq += __shfl_xor(sq, 32);
                if (fq == 0) ssn[(size_t)row * 16 + u.pn * 4 + wc] = sq; }
    }
};

struct StdOrder {
    const char* A; const char* Bt; size_t a_tile, b_tile;
    int nM, nN, nwg, G, c; int orow0, ocol0, ocstep; int tpl; size_t b_layer;
    int f1lo, f1hi, f2lo, f2hi;
    __device__ __forceinline__ bool next(int i, Unit& u) const {
        if (c < 0) return false;
        const long L = (long)i * G + c; if (L >= nwg) return false;
        int wgid = (int)L; { const int q = nwg / 8, r = nwg % 8, xcd = wgid % 8, off = wgid / 8; wgid = (xcd < r ? xcd * (q + 1) : r * (q + 1) + (xcd - r) * q) + off; }
        const int nig = 8 * nN, gid = wgid / nig, fm = gid * 8, gsz = (nM - fm) < 8 ? (nM - fm) : 8;
        const int pm = fm + ((wgid % nig) % gsz), pn = (wgid % nig) / gsz;
        u.a = A + (size_t)pm * a_tile; u.b = Bt + (size_t)pn * b_tile + (tpl ? (size_t)(pm / tpl) * b_layer : 0);
        u.orow = orow0 + pm * BM; u.ocol = ocol0 + pn * ocstep; u.pn = pn;
        u.aux = ((pn >= f1lo && pn < f1hi) ? 1 : 0) | ((pn >= f2lo && pn < f2hi) ? 2 : 0);
        return true;
    }
};
struct CmpOrder {
    const char* kvq; const char* w1; int c;
    __device__ __forceinline__ bool next(int i, Unit& u) const {
        if (i > 0 || c >= 128) return false;
        const int kv = c >> 6, b = (c >> 3) & 7, ks = c & 7;
        u.a = kvq + ((size_t)b * SEQ * NKVQ + kv * 128) * 2 + (size_t)ks * 4 * (NKVQ * 2); u.b = w1 + (size_t)kv * 256 * 2048 * 2 + (size_t)ks * 256 * 2;
        u.orow = b * 256; u.ocol = 0; u.pn = 0; u.aux = ks * 2 + kv; return true;
    }
};
struct MoeOrder {
    const LAS int* tb; const char* A; const char* Bt; size_t a_row, b_row; int G, c, nN, bn, ocstep, a_by_seg, xown;
    __device__ __forceinline__ bool next(int i, Unit& u) const {
        const int L = xown ? i * (G >> 3) + (c >> 3) : i * G + c; if (L >= tb[24]) return false;
        int e = 0;
#pragma unroll
        for (int k = 1; k < 8; ++k) e += (L >= tb[16 + k]) ? 1 : 0;
        const int local = L - tb[16 + e], te = tb[e], rt = local % te, seg = tb[8 + e]; int pn = local / te;
        if (xown) pn = ((c + e) & 7) + 8 * pn;
        const int arow = a_by_seg ? seg + rt * BM : e * M + rt * BM;
        u.a = A + (size_t)arow * a_row; u.b = Bt + ((size_t)e * bn + (size_t)pn * BM) * b_row;
        u.orow = seg + rt * BM; u.ocol = pn * ocstep; u.pn = pn; u.aux = a_by_seg ? 0 : e * M + rt * BM; return true;
    }
};
}

typedef GAS unsigned gu32;
#define RLX_AGENT __ATOMIC_RELAXED, __HIP_MEMORY_SCOPE_AGENT
#define XB_TMO      128
#define XB_XCNT(j)  (256  + 64 * (j))
#define XB_XSUB(j)  (1280 + 64 * (j))
#define XB_XGEN(j)  (2304 + 64 * (j))
#define XB_TOP      3328
#define XB_TOPGEN   3392
#define XCD_BAR_WORDS 3456
#define XB_SPIN_CAP (1u << 22)

__device__ __forceinline__ unsigned xb_ld(unsigned* p)              { return __hip_atomic_load(p, __ATOMIC_RELAXED, __HIP_MEMORY_SCOPE_AGENT); }
__device__ __forceinline__ unsigned xb_add(unsigned* p, unsigned v) { return __hip_atomic_fetch_add(p, v, __ATOMIC_RELAXED, __HIP_MEMORY_SCOPE_AGENT); }
__device__ __forceinline__ unsigned xb_xcc_id() { return (unsigned)__builtin_amdgcn_s_getreg((3 << 11) | 20) & 0xFu; }
#define XB_SPIN(cond, bar) do { unsigned _sp = 0; while (cond) { __builtin_amdgcn_s_sleep(1); \
    if ((++_sp & 255u) == 0u) { if (xb_ld(&(bar)[XB_TMO])) break; if (_sp > XB_SPIN_CAP) { atomicAdd(&(bar)[XB_TMO], 1u); break; } } } } while (0)

struct XcdBarrier { unsigned* bar; unsigned x; volatile LAS unsigned* st; };
__device__ __forceinline__ XcdBarrier xcd_barrier_post(unsigned* bar, volatile LAS unsigned* st, int wv) {
    XcdBarrier b; b.bar = bar; b.x = xb_xcc_id(); b.st = st;
    if (wv == 0 && lane_id() == 0) (void)xb_add(&bar[XB_XCNT(b.x)], 1u);
    return b;
}
__device__ __forceinline__ void xcd_barrier_complete(unsigned* bar, unsigned x, unsigned& nloc, unsigned& nx) {
    const unsigned G = gridDim.x * gridDim.y * gridDim.z;
    unsigned sum, cnt, mine, sp = 0u;
    for (;;) {
        sum = 0u; cnt = 0u; mine = 0u;
#pragma unroll
        for (unsigned j = 0; j < 16; ++j) { const unsigned c = xb_ld(&bar[XB_XCNT(j)]); sum += c; cnt += (c > 0u) ? 1u : 0u; mine = (j == x) ? c : mine; }
        if (sum == G) break;
        __builtin_amdgcn_s_sleep(1);
        if ((++sp & 255u) == 0u) { if (xb_ld(&bar[XB_TMO])) break; if (sp > XB_SPIN_CAP) { atomicAdd(&bar[XB_TMO], 1u); break; } }
    }
    nloc = mine > 0u ? mine : 1u; nx = cnt > 0u ? cnt : 1u;
}
__device__ __forceinline__ void xcd_barrier(const XcdBarrier& b, int wv) {
    asm volatile("s_waitcnt vmcnt(0)" ::: "memory");
    __syncthreads();
    if (wv == 0 && lane_id() == 0) {
        unsigned* bar = b.bar;
        __builtin_amdgcn_s_waitcnt(0);
        unsigned nloc = b.st[0], nx = b.st[1];
        if (nloc == 0u) { xcd_barrier_complete(bar, b.x, nloc, nx); b.st[0] = nloc; b.st[1] = nx; }
        const unsigned old = xb_add(&bar[XB_XSUB(b.x)], 1u);
        const unsigned gen = old / nloc;
        if (old + 1u == (gen + 1u) * nloc) {
            __builtin_amdgcn_fence(__ATOMIC_RELEASE, "agent");
            asm volatile("s_waitcnt vmcnt(0)" ::: "memory");
            const unsigned og = xb_add(&bar[XB_TOP], 1u);
            const unsigned tg = og / nx;
            if (og + 1u == (tg + 1u) * nx) xb_add(&bar[XB_TOPGEN], 1u);
            else XB_SPIN(xb_ld(&bar[XB_TOPGEN]) == tg, bar);
            __builtin_amdgcn_fence(__ATOMIC_ACQUIRE, "agent");
            xb_add(&bar[XB_XGEN(b.x)], 1u);
            asm volatile("s_waitcnt vmcnt(0)" ::: "memory");
        } else {
            XB_SPIN(xb_ld(&bar[XB_XGEN(b.x)]) == gen, bar);
            __builtin_amdgcn_fence(__ATOMIC_ACQUIRE, "agent");
            asm volatile("s_waitcnt vmcnt(0)" ::: "memory");
        }
    }
    __syncthreads();
}

struct Args { const float* in[33]; float* out; unsigned char* ws; int ph_lo, ph_hi; };
typedef const Args __attribute__((address_space(4))) * KArgs;
struct Frame {
    LAS unsigned char* lds; volatile LAS unsigned* MISC; unsigned* ctl;
    int tid, lane, wave, vcu, G;
    unsigned char* ws;
};

struct TrDesc { const float* src; bf16_t* dst; const float* gain; int K, N, Npad, nb; size_t sbs, dbs; int gdiv, gstride, map, drow0, f8, b0; float qs; unsigned* amax; };
__device__ __forceinline__ int tr_items(const TrDesc& d) { return (d.K / 64) * (d.Npad / 64) * d.nb; }
__device__ __forceinline__ void tr_load(const TrDesc& d, int item, int lane, f32x4 (&va)[8], f32x4 (&vb)[8]) {
    const int nblk = d.Npad / 64, per = nblk * (d.K / 64);
    const int b = d.b0 + item / per, r = item % per, kb = r / nblk, nbk = r % nblk, k0 = 64 * kb, n0 = 64 * nbk;
    const float* W = d.src + (size_t)b * d.sbs;
    const int l16 = lane & 15, kq = lane >> 4, n = n0 + 4 * l16; const bool valid = n < d.N;
#pragma unroll
    for (int i = 0; i < 8; ++i) { const int k = k0 + 2 * (4 * i + kq);
        va[i] = valid ? __builtin_nontemporal_load((const f32x4*)(W + (size_t)k * d.N + n)) : (f32x4){0.f, 0.f, 0.f, 0.f};
        vb[i] = valid ? __builtin_nontemporal_load((const f32x4*)(W + (size_t)(k + 1) * d.N + n)) : (f32x4){0.f, 0.f, 0.f, 0.f}; }
}
__device__ __forceinline__ void tr_finish(const TrDesc& d, int item, int lane, const f32x4 (&va)[8], const f32x4 (&vb)[8], LAS unsigned* scr) {
    const int nblk = d.Npad / 64, per = nblk * (d.K / 64);
    const int b = d.b0 + item / per, r = item % per, kb = r / nblk, nbk = r % nblk, k0 = 64 * kb, n0 = 64 * nbk;
    const float* gn = d.gain ? d.gain + (size_t)(b / d.gdiv) * d.gstride : nullptr;
    const int l16 = lane & 15, kq = lane >> 4; float amx = 0.f;
#pragma unroll
    for (int i = 0; i < 8; ++i) { const int kp = 4 * i + kq; float ga = 1.f, gb = 1.f; if (gn) { ga = gn[k0 + 2 * kp]; gb = gn[k0 + 2 * kp + 1]; }
        if (d.f8 == 1) {
#pragma unroll
            for (int e = 0; e < 4; ++e) ((LAS unsigned short*)scr)[(4 * l16 + e) * 34 + kp] = (unsigned short)__builtin_amdgcn_cvt_pk_fp8_f32(va[i][e] * (ga * 64.f), vb[i][e] * (gb * 64.f), 0, false);
        } else if (d.f8 == 3) {
#pragma unroll
            for (int e = 0; e < 4; ++e) { const int qa = (int)__builtin_rintf(va[i][e] * (ga * d.qs)), qb = (int)__builtin_rintf(vb[i][e] * (gb * d.qs)); ((LAS unsigned short*)scr)[(4 * l16 + e) * 34 + kp] = (unsigned short)((qa & 0xFF) | ((qb & 0xFF) << 8)); }
        } else if (d.f8 == 2) {
#pragma unroll
            for (int e = 0; e < 4; ++e) amx = fmaxf(amx, fmaxf(fabsf(va[i][e] * ga), fabsf(vb[i][e] * gb)));
        } else {
#pragma unroll
            for (int e = 0; e < 4; ++e) scr[(4 * l16 + e) * 33 + kp] = pk2(va[i][e] * ga, vb[i][e] * gb); } }
    if (d.f8 == 2) {
#pragma unroll
        for (int o = 1; o < 64; o <<= 1) amx = fmaxf(amx, __shfl_xor(amx, o));
        if (lane == 0 && __builtin_bit_cast(unsigned, amx) > __hip_atomic_load(d.amax + 64 * b, __ATOMIC_RELAXED, __HIP_MEMORY_SCOPE_AGENT))
            __hip_atomic_fetch_max(d.amax + 64 * b, __builtin_bit_cast(unsigned, amx), __ATOMIC_RELAXED, __HIP_MEMORY_SCOPE_AGENT);
        return; }
    LDS_WAIT(); asm volatile("" ::: "memory");
    int dr;
    if (d.map == 1) { const int half = d.N / 2, hh = n0 / half, nn = n0 % half; dr = (nn / 128) * 256 + hh * 128 + (nn % 128); } else dr = d.drow0 + n0;
    if (d.f8 == 1 || d.f8 == 3) {
        unsigned char* W8 = (unsigned char*)d.dst + (size_t)b * d.dbs; const int c4 = lane & 3;
#pragma unroll
        for (int j = 0; j < 4; ++j) { const int nl = (lane >> 2) + 16 * j; const LAS unsigned* sp = scr + nl * 17 + 4 * c4;
            u32x4 o; o.x = sp[0]; o.y = sp[1]; o.z = sp[2]; o.w = sp[3];
            *(u32x4*)(W8 + (size_t)(dr + nl) * d.K + k0 + 16 * c4) = o; }
        LDS_WAIT(); asm volatile("" ::: "memory");
        return;
    }
    bf16_t* WT = d.dst + (size_t)b * d.dbs;
    const int c = lane & 7;
#pragma unroll
    for (int j = 0; j < 8; ++j) { const int nl = (lane >> 3) + 8 * j; const LAS unsigned* sp = scr + nl * 33 + 4 * c;
        u32x4 o; o.x = sp[0]; o.y = sp[1]; o.z = sp[2]; o.w = sp[3];
        *(u32x4*)(WT + (size_t)(dr + nl) * d.K + k0 + 8 * c) = o; }
    LDS_WAIT(); asm volatile("" ::: "memory");
}
constexpr int N_TR = 13;
__device__ __forceinline__ TrDesc tr_desc(int kind, int stage, KArgs a, unsigned char* ws) { TrDesc d; d.gain = nullptr; d.b0 = 0; d.qs = 1.f; d.amax = (unsigned*)ws + CW_WMAX; d.gdiv = 1; d.gstride = 0; d.map = 0; d.drow0 = 0;
    switch (kind) {
    case 0:  d.src = a->in[6];  d.dst = (bf16_t*)(ws + WS_WIN);  d.K = 1024; d.N = 2048; d.nb = 2;  d.gain = a->in[2]; d.gstride = 1024; break;
    case 1:  d.src = a->in[14]; d.dst = (bf16_t*)(ws + WS_WOUT); d.K = 1024; d.N = 1024; d.nb = 2;  break;
    case 2:  d.src = a->in[26]; d.dst = (bf16_t*)(ws + WS_WGU);  d.K = 1024; d.N = 6144; d.nb = 2;  d.gain = a->in[3]; d.gstride = 2048; d.map = 1; break;
    case 3:  d.src = a->in[27]; d.dst = (bf16_t*)(ws + WS_WDN);  d.K = 3072; d.N = 1024; d.nb = 2;  break;
    case 4:  d.src = a->in[29]; d.dst = (bf16_t*)(ws + WS_WMGU); d.K = 1024; d.N = 7168; d.nb = 16; d.gain = a->in[3] + 1024; d.gdiv = 8; d.gstride = 2048; d.map = 1; break;
    case 5:  d.src = a->in[30]; d.dst = (bf16_t*)(ws + WS_WMDN); d.K = 3584; d.N = 1024; d.nb = 16; break;
    case 6:  d.src = a->in[32]; d.dst = (bf16_t*)(ws + WS_WPG);  d.K = 1024; d.N = 1024; d.nb = 4;  d.gain = a->in[4]; d.gstride = 1024; break;
    case 7:  d.src = a->in[31]; d.dst = (bf16_t*)(ws + WS_WPP);  d.K = 256;  d.N = 1024; d.nb = 4;  break;
    case 8:  d.src = a->in[16]; d.dst = (bf16_t*)(ws + WS_WKVQ); d.K = 1024; d.N = 768;  d.nb = 1;  d.gain = a->in[15]; break;
    case 9:  d.src = a->in[24]; d.dst = (bf16_t*)(ws + WS_WKVQ); d.K = 1024; d.N = 1072; d.nb = 2;  d.gain = a->in[2] + 2048; d.gstride = 1024; d.drow0 = 768; break;
    case 10: d.src = a->in[25]; d.dst = (bf16_t*)(ws + WS_WO);   d.K = 1024; d.N = 1024; d.nb = 2;  break;
    case 11: d.src = a->in[19]; d.dst = (bf16_t*)(ws + WS_WC1);  d.K = 2048; d.N = 256;  d.nb = 1;  break;
    default: d.src = a->in[21]; d.dst = (bf16_t*)(ws + WS_WC1) + 256 * 2048; d.K = 2048; d.N = 256; d.nb = 1; break;
    }
    d.Npad = (kind == 9) ? 1280 : d.N; d.f8 = (kind == 4 || kind == 5) ? 1 : 0;
    d.sbs = (size_t)d.K * d.N; d.dbs = (size_t)d.K * ((kind == 9 || kind == 8) ? 2048 : d.N);
    if (kind == 2) d.f8 = (stage >= 3) ? 3 : 2;
    if (stage >= 3) { if (kind == 2) { d.b0 = stage - 3; d.nb = 1; const float wm = __builtin_bit_cast(float, __hip_atomic_load(d.amax + 64 * d.b0, __ATOMIC_RELAXED, __HIP_MEMORY_SCOPE_AGENT)); d.qs = wm > 0.f ? 127.0f / wm : 0.f; } else d.nb = 0; return d; }
    if (stage == 0) { if (kind == 2 || kind == 3) d.nb = 1; else if (kind == 4 || kind == 5) d.nb = 8; else if (kind == 6) d.nb = 2; else if (kind == 10) d.nb = 0; }
    else if (stage == 1) { if (kind == 2 || kind == 3) { d.b0 = 1; d.nb = 1; } else if (kind == 6) { d.b0 = 2; d.nb = 2; } else if (kind == 10) { d.b0 = 0; d.nb = 2; } else if (kind == 4 || kind == 5) { d.b0 = 8; d.nb = 4; } else d.nb = 0; }
    else { if (kind == 4 || kind == 5) { d.b0 = 12; d.nb = 4; } else d.nb = 0; }
    return d;
}
__device__ __forceinline__ void tr_run(KArgs a, unsigned char* ws, int stage, int gwe, int nge, LAS unsigned* scr, int lane) {
    int base = 0;
    for (int kind = 0; kind < N_TR; ++kind) {
        const TrDesc d = tr_desc(kind, stage, a, ws); const int n = tr_items(d);
        if (n == 0) continue;
        int first = gwe - (base % nge); if (first < 0) first += nge;
        if (first < n) {
            f32x4 a0[8], b0[8], a1[8], b1[8]; int it = first;
            tr_load(d, it, lane, a0, b0);
            for (;;) {
                const int it1 = it + nge; const bool h1 = it1 < n; if (h1) tr_load(d, it1, lane, a1, b1);
                __builtin_amdgcn_sched_barrier(0);
                tr_finish(d, it, lane, a0, b0, scr);
                if (!h1) break;
                const int it2 = it1 + nge; const bool h2 = it2 < n; if (h2) tr_load(d, it2, lane, a0, b0);
                __builtin_amdgcn_sched_barrier(0);
                tr_finish(d, it1, lane, a1, b1, scr);
                if (!h2) break;
                it = it2;
            }
        }
        base += n;
    }
}
__device__ __forceinline__ void p0_prologue(Frame& F, KArgs a) {
    LAS unsigned* scr = (LAS unsigned*)(F.lds + RING_OFF + F.wave * 16384);
    const int gw = F.vcu * NWAVES + F.wave, NGW = F.G * NWAVES;
    tr_run(a, F.ws, 0, gw, NGW, scr, F.lane);
    { const float* x = a->in[0]; bf16_t* xb = (bf16_t*)(F.ws + WS_XB0); float* ss = (float*)(F.ws + WS_SS0);
      for (int m0 = gw * 4; m0 < M; m0 += NGW * 4) {
          f32x4 v[4][4];
#pragma unroll
          for (int q = 0; q < 4; ++q)
#pragma unroll
              for (int j = 0; j < 4; ++j) v[q][j] = ((const f32x4*)(x + (size_t)(m0 + q) * DM) + F.lane)[64 * j];
#pragma unroll
          for (int q = 0; q < 4; ++q) { float s = 0.f; u32x2* o8 = (u32x2*)(xb + (size_t)(m0 + q) * DM) + F.lane;
#pragma unroll
              for (int j = 0; j < 4; ++j) { const f32x4 vv = v[q][j]; s += (vv[0] * vv[0] + vv[1] * vv[1]) + (vv[2] * vv[2] + vv[3] * vv[3]); u32x2 w; w.x = pk2(vv[0], vv[1]); w.y = pk2(vv[2], vv[3]); o8[64 * j] = w; }
              s = wave_sum(s);
              if (F.lane < 16) ss[(size_t)(m0 + q) * 16 + F.lane] = (F.lane == 0) ? s : 0.f; } } }
    { const float* p = a->in[1]; bf16_t* pb = (bf16_t*)(F.ws + WS_PB); const size_t n8 = (size_t)4 * M * DPLE / 8;
      for (size_t i = (size_t)opaque_s((int)blockIdx.x) * 512 + F.tid; i < n8; i += (size_t)F.G * 512) {
          const f32x4 v0 = *(const f32x4*)(p + i * 8), v1 = *(const f32x4*)(p + i * 8 + 4);
          u32x4 w; w.x = pk2(v0[0], v0[1]); w.y = pk2(v0[2], v0[3]); w.z = pk2(v1[0], v1[1]); w.w = pk2(v1[2], v1[3]);
          *(u32x4*)(pb + i * 8) = w; } }
    { float* cb = (float*)(F.ws + WS_SMALL);
      for (int o = gw; o < 512; o += NGW) { const int kv = o >> 8, j = o & 255; const float* pos = a->in[17 + kv]; const float* w1 = a->in[kv ? 21 : 19];
          float s = 0.f; for (int k = F.lane; k < 2048; k += 64) s += pos[k] * w1[(size_t)k * 256 + j];
          s = wave_sum(s); if (F.lane == 0) cb[o] = s; } }
}

__device__ __forceinline__ void rg_phase(Frame& F, KArgs a, int la) {
    const bf16_t* GX = (const bf16_t*)(F.ws + WS_GXK); bf16_t* Y = (bf16_t*)(F.ws + WS_YO);
    const float* conv_w = a->in[7] + (size_t)la * 4 * 1024; const float* conv_b = a->in[8] + (size_t)la * 1024;
    const float* w_a = a->in[9] + (size_t)la * 16 * 64 * 64; const float* b_a = a->in[10] + (size_t)la * 1024;
    const float* w_x = a->in[11] + (size_t)la * 16 * 64 * 64; const float* b_x = a->in[12] + (size_t)la * 1024;
    const float* lam = a->in[13] + (size_t)la * 1024;
    LAS bf16_t* xcb = (LAS bf16_t*)(F.lds + RING_OFF);
    LAS float* cw = (LAS float*)(F.lds + RING_OFF + 40960);
    LAS float* wtot = (LAS float*)(F.lds + RING_OFF + 43008);
    const int lane = F.lane, w = F.wave, fr = lane & 15, fq = lane >> 4;
    for (int unit = opaque_s((int)blockIdx.x); unit < 256; unit += F.G) {
        const int b = unit >> 5, n = (unit >> 1) & 15, oc = unit & 1;
        __syncthreads();
        if (F.tid < 256) cw[F.tid] = conv_w[(size_t)(F.tid >> 6) * 1024 + n * 64 + (F.tid & 63)];
        else if (F.tid < 320) cw[F.tid] = conv_b[n * 64 + (F.tid - 256)];
        float ba[2], bx[2], sp[2]; bf16x8 wa[2][2], wx[2][2];
#pragma unroll
        for (int nt = 0; nt < 2; ++nt) { const int ch = n * 64 + oc * 32 + nt * 16 + fr; ba[nt] = b_a[ch]; bx[nt] = b_x[ch];
            const float l = lam[ch]; sp[nt] = (l > 15.f) ? __expf(-l) : log1pf(__expf(-l));
#pragma unroll
            for (int ks = 0; ks < 2; ++ks) {
                const float* pa = w_a + ((size_t)n * 64 + ks * 32 + fq * 8) * 64 + oc * 32 + nt * 16 + fr; const float* px = w_x + ((size_t)n * 64 + ks * 32 + fq * 8) * 64 + oc * 32 + nt * 16 + fr;
                u32x4 ua, ux; ua.x = pk2(pa[0], pa[64]); ua.y = pk2(pa[128], pa[192]); ua.z = pk2(pa[256], pa[320]); ua.w = pk2(pa[384], pa[448]);
                ux.x = pk2(px[0], px[64]); ux.y = pk2(px[128], px[192]); ux.z = pk2(px[256], px[320]); ux.w = pk2(px[384], px[448]);
                wa[ks][nt] = __builtin_bit_cast(bf16x8, ua); wx[ks][nt] = __builtin_bit_cast(bf16x8, ux); } }
        float carry[2] = {0.f, 0.f};
        __syncthreads();
        u32x4 cv[2][4];
#define RG_LOAD_CONV(chunk_) do { _Pragma("unroll") for (int ii = 0; ii < 2; ++ii) { const int it = F.tid + ii * 512, tok = it >> 3, g8 = it & 7, t = (chunk_) * 128 + tok; \
            _Pragma("unroll") for (int k = 0; k < 4; ++k) { const int tt = t - 3 + k; cv[ii][k] = (tt >= 0) ? *(const u32x4*)(GX + ((size_t)(b * SEQ + tt)) * 2048 + 1024 + n * 64 + g8 * 8) : (u32x4){0u, 0u, 0u, 0u}; } } } while (0)
        RG_LOAD_CONV(0);
        for (int chunk = 0; chunk < 16; ++chunk) {
            const int buf = chunk & 1; LAS bf16_t* xc = xcb + buf * (128 * 72);
#pragma unroll
            for (int ii = 0; ii < 2; ++ii) { const int it = F.tid + ii * 512, tok = it >> 3, g8 = it & 7;
                float ac[8];
#pragma unroll
                for (int e = 0; e < 8; ++e) ac[e] = cw[256 + g8 * 8 + e];
#pragma unroll
                for (int k = 0; k < 4; ++k) { const u32x4 v = cv[ii][k];
                    const LAS float* ck = cw + k * 64 + g8 * 8;
                    ac[0] += ck[0] * bflo(v.x); ac[1] += ck[1] * bfhi(v.x); ac[2] += ck[2] * bflo(v.y); ac[3] += ck[3] * bfhi(v.y);
                    ac[4] += ck[4] * bflo(v.z); ac[5] += ck[5] * bfhi(v.z); ac[6] += ck[6] * bflo(v.w); ac[7] += ck[7] * bfhi(v.w); }
                u32x4 o; o.x = pk2(ac[0], ac[1]); o.y = pk2(ac[2], ac[3]); o.z = pk2(ac[4], ac[5]); o.w = pk2(ac[6], ac[7]);
                *(LAS u32x4*)(xc + tok * 72 + g8 * 8) = o; }
            if (chunk + 1 < 16) RG_LOAD_CONV(chunk + 1);
            bf16_t gq[2][4];
#pragma unroll
            for (int nt = 0; nt < 2; ++nt)
#pragma unroll
                for (int e = 0; e < 4; ++e) gq[nt][e] = GX[((size_t)b * SEQ + chunk * 128 + 16 * w + 4 * fq + e) * 2048 + n * 64 + oc * 32 + nt * 16 + fr];
            __syncthreads();
            f32x4 ra[2], xi[2];
            { const bf16x8 A0 = *(const LAS bf16x8*)(xc + (16 * w + fr) * 72 + fq * 8), A1 = *(const LAS bf16x8*)(xc + (16 * w + fr) * 72 + 32 + fq * 8);
#pragma unroll
              for (int nt = 0; nt < 2; ++nt) {
                  ra[nt] = __builtin_amdgcn_mfma_f32_16x16x32_bf16(A0, wa[0][nt], (f32x4){0.f, 0.f, 0.f, 0.f}, 0, 0, 0); ra[nt] = __builtin_amdgcn_mfma_f32_16x16x32_bf16(A1, wa[1][nt], ra[nt], 0, 0, 0);
                  xi[nt] = __builtin_amdgcn_mfma_f32_16x16x32_bf16(A0, wx[0][nt], (f32x4){0.f, 0.f, 0.f, 0.f}, 0, 0, 0); xi[nt] = __builtin_amdgcn_mfma_f32_16x16x32_bf16(A1, wx[1][nt], xi[nt], 0, 0, 0); } }
            float hl[2][4], pl[2][4], Pw[2], Hw[2];
#pragma unroll
            for (int nt = 0; nt < 2; ++nt) { float H = 0.f, P = 1.f;
#pragma unroll
                for (int e = 0; e < 4; ++e) { const int tok = 16 * w + 4 * fq + e;
                    const float xv = bf1(xc[tok * 72 + oc * 32 + nt * 16 + fr]);
                    const float r = sigmoidf_(ra[nt][e] + ba[nt]), ig = sigmoidf_(xi[nt][e] + bx[nt]);
                    const float la_ = -8.0f * r * sp[nt], av = ex2(la_ * LOG2E), t2 = 2.0f * la_;
                    const float om = -t2 * (1.0f + t2 * (0.5f + t2 * (0.16666667f + t2 * (0.041666668f + t2 * 0.0083333338f))));
                    const float uu = __builtin_sqrtf(fmaxf(om, 0.f)) * ig * xv;
                    H = av * H + uu; P = P * av; hl[nt][e] = H; pl[nt][e] = P; }
                float Pi = P, Hi = H;
                { const float Pp = __shfl_up(Pi, 16), Hp = __shfl_up(Hi, 16); if (fq >= 1) { Hi = Pi * Hp + Hi; Pi = Pi * Pp; } }
                { const float Pp = __shfl_up(Pi, 32), Hp = __shfl_up(Hi, 32); if (fq >= 2) { Hi = Pi * Hp + Hi; Pi = Pi * Pp; } }
                float Pe = __shfl_up(Pi, 16), He = __shfl_up(Hi, 16); if (fq == 0) { Pe = 1.f; He = 0.f; }
                if (fq == 3) { wtot[((buf * 8 + w) * 32 + nt * 16 + fr) * 2] = Pi; wtot[((buf * 8 + w) * 32 + nt * 16 + fr) * 2 + 1] = Hi; }
                Pw[nt] = Pe; Hw[nt] = He; }
            __syncthreads();
#pragma unroll
            for (int nt = 0; nt < 2; ++nt) { float c = carry[nt], cin = 0.f;
#pragma unroll
                for (int ww = 0; ww < 8; ++ww) { const float A_ = wtot[((buf * 8 + ww) * 32 + nt * 16 + fr) * 2], H_ = wtot[((buf * 8 + ww) * 32 + nt * 16 + fr) * 2 + 1];
                    if (ww == w) cin = c; c = A_ * c + H_; }
                carry[nt] = c;
                const float cl = Pw[nt] * cin + Hw[nt];
#pragma unroll
                for (int e = 0; e < 4; ++e) { const size_t row = (size_t)b * SEQ + chunk * 128 + 16 * w + 4 * fq + e; const int ch = n * 64 + oc * 32 + nt * 16 + fr;
                    const float hv = hl[nt][e] + pl[nt][e] * cl; const float gg = bf1(gq[nt][e]);
                    Y[row * DM + ch] = (bf16_t)f2bf(gg * hv); } }
        }
    }
}

#undef RG_LOAD_CONV
__device__ __forceinline__ int crow(int r, int hi) { return (r & 3) + 8 * (r >> 2) + 4 * hi; }
__device__ __forceinline__ int rel_bucket_i(int n) {
    if (n < 16) return n;
    return 16 + (n >= 19) + (n >= 21) + (n >= 24) + (n >= 27) + (n >= 31) + (n >= 35) + (n >= 40) + (n >= 46) + (n >= 52) + (n >= 59) + (n >= 67) + (n >= 77) + (n >= 87) + (n >= 99) + (n >= 113);
}
__device__ __forceinline__ float sum8_dpp(float v) {
    v += __builtin_bit_cast(float, __builtin_amdgcn_update_dpp(0, __builtin_bit_cast(int, v), 0xB1, 0xF, 0xF, false));
    v += __builtin_bit_cast(float, __builtin_amdgcn_update_dpp(0, __builtin_bit_cast(int, v), 0x4E, 0xF, 0xF, false));
    v += __builtin_bit_cast(float, __builtin_amdgcn_update_dpp(0, __builtin_bit_cast(int, v), 0x141, 0xF, 0xF, false));
    return v;
}
struct KVF { bf16x8 k[4]; bf16x8 v[2][2]; };
__device__ __forceinline__ void load_k(KVF& t, const char* tile, unsigned loff) {
#pragma unroll
    for (int d0 = 0; d0 < 4; ++d0) t.k[d0] = *(const bf16x8*)(tile + loff + d0 * 1024);
}
__device__ __forceinline__ void load_v(KVF& t, const char* tile, unsigned loff) {
#pragma unroll
    for (int dt = 0; dt < 2; ++dt)
#pragma unroll
        for (int s = 0; s < 2; ++s) t.v[dt][s] = *(const bf16x8*)(tile + loff + (dt * 2 + s) * 1024);
}
__device__ __forceinline__ f32x16 attn_qk(const KVF& t, const bf16x8 (&qr)[4], float init) {
    f32x16 s;
#pragma unroll
    for (int r = 0; r < 16; ++r) s[r] = init;
#pragma unroll
    for (int d0 = 0; d0 < 4; ++d0) s = __builtin_amdgcn_mfma_f32_32x32x16_bf16(t.k[d0], qr[d0], s, 0, 0, 0);
    return s;
}
__device__ __forceinline__ void attn_pv(const f32x16& P, f32x16 (&o)[2], const KVF& t) {
#pragma unroll
    for (int s = 0; s < 2; ++s) {
        u32x4 pw; pw.x = pk2(P[8 * s + 0], P[8 * s + 1]); pw.y = pk2(P[8 * s + 2], P[8 * s + 3]); pw.z = pk2(P[8 * s + 4], P[8 * s + 5]); pw.w = pk2(P[8 * s + 6], P[8 * s + 7]);
        const bf16x8 pb = __builtin_bit_cast(bf16x8, pw);
#pragma unroll
        for (int dt = 0; dt < 2; ++dt) o[dt] = __builtin_amdgcn_mfma_f32_32x32x16_bf16(t.v[dt][s], pb, o[dt], 0, 0, 0); }
}
__device__ __forceinline__ float max3f(float a, float b, float c) { float r; asm("v_max3_f32 %0, %1, %2, %3" : "=v"(r) : "v"(a), "v"(b), "v"(c)); return r; }
typedef float f32x8 __attribute__((ext_vector_type(8)));
__device__ __forceinline__ void attn_step(f32x16& S, float cb, float& m, float& l, f32x16 (&o)[2], const KVF& t) {
    float mx = max3f(S[0], S[1], S[2]);
#pragma unroll
    for (int r = 3; r < 15; r += 2) mx = max3f(mx, S[r], S[r + 1]);
    mx = fmaxf(mx, S[15]);
    mx = fmaxf(mx, __shfl_xor(mx, 32)) + cb;
    const float mn = fmaxf(m, mx), dlt = cb - mn;
    float rs = 0.f;
#pragma unroll
    for (int r = 0; r < 16; ++r) { S[r] = ex2(S[r] + dlt); rs += S[r]; }
    rs += __shfl_xor(rs, 32);
    if (__any(mn > m)) { const float alpha = ex2(m - mn); l *= alpha;
#pragma unroll
        for (int dt = 0; dt < 2; ++dt)
#pragma unroll
            for (int r = 0; r < 16; ++r) o[dt][r] *= alpha; }
    l += rs; m = mn;
    attn_pv(S, o, t);
}
template <int WIN>
__device__ __forceinline__ float attn_scores(f32x16& S, const bf16x8 (&k)[4], int tt, const bf16x8 (&qr)[4], unsigned sel, int s0, int stok, int hi, const LAS float* lut_h, float c31) {
    const int key0 = 32 * tt; const bool selc = WIN ? true : (((sel >> (tt >> 1)) & 1u) != 0u);
    const bool far = WIN ? (s0 - (key0 + 31) >= 127 && s0 + 3 - key0 <= 511) : (s0 - (key0 + 31) >= 127);
#pragma unroll
    for (int r = 0; r < 16; ++r) S[r] = 0.f;
#pragma unroll
    for (int d0 = 0; d0 < 4; ++d0) S = __builtin_amdgcn_mfma_f32_32x32x16_bf16(k[d0], qr[d0], S, 0, 0, 0);
    if (far) return selc ? c31 : -1e30f;
    const LAS float* p = lut_h + (stok - key0 - 4 * hi - 27);
#pragma unroll
    for (int r = 0; r < 16; ++r) S[r] += p[27 - ((r & 3) + 8 * (r >> 2))];
    return selc ? 0.f : -1e30f;
}
__device__ __forceinline__ float rowmax16(const f32x16& S) {
    float mx = max3f(S[0], S[1], S[2]);
#pragma unroll
    for (int r = 3; r < 15; r += 2) mx = max3f(mx, S[r], S[r + 1]);
    return fmaxf(mx, S[15]);
}
__device__ __forceinline__ void attn_pv2(const f32x16& P, f32x16 (&o)[2], const bf16x8 (&v)[2][2]) {
#pragma unroll
    for (int s = 0; s < 2; ++s) {
        u32x4 pw; pw.x = pk2(P[8 * s + 0], P[8 * s + 1]); pw.y = pk2(P[8 * s + 2], P[8 * s + 3]); pw.z = pk2(P[8 * s + 4], P[8 * s + 5]); pw.w = pk2(P[8 * s + 6], P[8 * s + 7]);
        const bf16x8 pb = __builtin_bit_cast(bf16x8, pw);
#pragma unroll
        for (int dt = 0; dt < 2; ++dt) o[dt] = __builtin_amdgcn_mfma_f32_32x32x16_bf16(v[dt][s], pb, o[dt], 0, 0, 0); }
}
__device__ __forceinline__ float exp2_fast(float s, float c23) {
    float r; asm("v_cvt_u32_f32 %0, %1" : "=v"(r) : "v"(__builtin_fmaf(s, 8388608.0f, c23))); return r;
}
template <int WIN>
__device__ __forceinline__ void attn_pair(const bf16x8 (&k0)[4], const bf16x8 (&k1)[4], const bf16x8 (&v0)[2][2], const bf16x8 (&v1)[2][2], int t0, int t1, const bf16x8 (&qr)[4],
                                          float& m, float& l, f32x16 (&o)[2], unsigned sel, int s0, int stok, int hi, const LAS float* lut_h, float c31) {
    f32x16 S0, S1; float cb1 = -1e30f;
    const float cb0 = attn_scores<WIN>(S0, k0, t0, qr, sel, s0, stok, hi, lut_h, c31);
    if (t1 >= 0) cb1 = attn_scores<WIN>(S1, k1, t1, qr, sel, s0, stok, hi, lut_h, c31);
    else {
#pragma unroll
        for (int r = 0; r < 16; ++r) S1[r] = 0.f; }
    float mx = fmaxf(rowmax16(S0) + cb0, rowmax16(S1) + cb1);
    mx = fmaxf(mx, __shfl_xor(mx, 32));
    const float mn = fmaxf(m, mx), c0 = fmaxf((cb0 - mn + 127.0f) * 8388608.0f, -3.0e38f), c1 = fmaxf((cb1 - mn + 127.0f) * 8388608.0f, -3.0e38f);
    float rs = 0.f;
#pragma unroll
    for (int r = 0; r < 16; ++r) { S0[r] = exp2_fast(S0[r], c0); S1[r] = exp2_fast(S1[r], c1); rs += S0[r] + S1[r]; }
    rs += __shfl_xor(rs, 32);
    if (__any(mn > m)) { const float alpha = ex2(m - mn); l *= alpha;
#pragma unroll
        for (int dt = 0; dt < 2; ++dt)
#pragma unroll
            for (int r = 0; r < 16; ++r) o[dt][r] *= alpha; }
    l += rs; m = mn;
    attn_pv2(S0, o, v0);
    if (t1 >= 0) attn_pv2(S1, o, v1);
}
template <int WIN>
__device__ __forceinline__ void attn_branch(unsigned long long TM, const char* Kb, const char* Vb, unsigned loff, const bf16x8 (&qr)[4], LAS float* ost, float gate,
                                            unsigned sel, int s0, int stok, int hi, const LAS float* lut_h, float c31) {
    float m = -1e30f, l = 0.f; f32x16 o[2];
#pragma unroll
    for (int r = 0; r < 16; ++r) { o[0][r] = 0.f; o[1][r] = 0.f; }
#define POP_TILE(T) (WIN ? (63 - __builtin_clzll(T)) : __builtin_ctzll(T))
#define POP2(ta, tb) do { ta = -1; tb = -1; if (TM != 0ull) { ta = POP_TILE(TM); TM &= ~(1ull << ta); if (TM != 0ull) { tb = POP_TILE(TM); TM &= ~(1ull << tb); } } } while (0)
#define LOAD_K2(X, ta, tb) do { if ((ta) >= 0) { _Pragma("unroll") for (int d0 = 0; d0 < 4; ++d0) X[0][d0] = *(const bf16x8*)(Kb + (size_t)(ta) * 4096 + loff + d0 * 1024); } \
                                if ((tb) >= 0) { _Pragma("unroll") for (int d0 = 0; d0 < 4; ++d0) X[1][d0] = *(const bf16x8*)(Kb + (size_t)(tb) * 4096 + loff + d0 * 1024); } } while (0)
#define LOAD_V2(ta, tb) do { _Pragma("unroll") for (int q = 0; q < 4; ++q) va[0][q >> 1][q & 1] = *(const bf16x8*)(Vb + (size_t)(ta) * 4096 + loff + q * 1024); \
                             if ((tb) >= 0) { _Pragma("unroll") for (int q = 0; q < 4; ++q) va[1][q >> 1][q & 1] = *(const bf16x8*)(Vb + (size_t)(tb) * 4096 + loff + q * 1024); } } while (0)
    bf16x8 ka[2][4], kb[2][4], va[2][2][2];
    int a0, a1, b0, b1;
    POP2(a0, a1); LOAD_K2(ka, a0, a1);
    for (;;) {
        LOAD_V2(a0, a1);
        POP2(b0, b1); LOAD_K2(kb, b0, b1);
        __builtin_amdgcn_sched_barrier(0);
        attn_pair<WIN>(ka[0], ka[1], va[0], va[1], a0, a1, qr, m, l, o, sel, s0, stok, hi, lut_h, c31);
        if (b0 < 0) break;
        LOAD_V2(b0, b1);
        POP2(a0, a1); LOAD_K2(ka, a0, a1);
        __builtin_amdgcn_sched_barrier(0);
        attn_pair<WIN>(kb[0], kb[1], va[0], va[1], b0, b1, qr, m, l, o, sel, s0, stok, hi, lut_h, c31);
        if (a0 < 0) break;
    }
#undef POP_TILE
#undef POP2
#undef LOAD_K2
#undef LOAD_V2
    const float sc_ = gate / l;
#pragma unroll
    for (int dt = 0; dt < 2; ++dt)
#pragma unroll
        for (int r = 0; r < 16; ++r) ost[(dt * 16 + r) * 64] += sc_ * o[dt][r];
}
__device__ __forceinline__ void attn_phase(Frame& F, KArgs a, int slab) {
    const bf16_t* KVQ = (const bf16_t*)(F.ws + WS_GXK); const bf16_t* KC = (const bf16_t*)(F.ws + WS_KC); const bf16_t* VTC = KC + 16 * 128 * 64;
    const bf16_t* VTS = (const bf16_t*)(F.ws + WS_VTS); const bf16_t* VTW = (const bf16_t*)(F.ws + WS_VTW); bf16_t* O = (bf16_t*)(F.ws + WS_YO);
    const bf16_t* KFS = (const bf16_t*)(F.ws + WS_KFS); const bf16_t* KFW = (const bf16_t*)(F.ws + WS_KFW);
    LAS float* lut = (LAS float*)(F.lds + RING_OFF);
    __syncthreads();
    constexpr int LSTR = 612, LOFF = 40;
    for (int i = F.tid; i < 16 * LSTR; i += 512) { const int h = i / LSTR, d = i % LSTR - LOFF; lut[i] = (d >= 0 && d < 512) ? a->in[23][rel_bucket_i(d > 127 ? 127 : d) * 16 + h] * LOG2E : -1e30f; }
    __syncthreads();
    const int lane0 = F.lane, w = F.wave;
    LAS unsigned* scr = (LAS unsigned*)(F.lds + RING_OFF + 40960 + F.wave * 10240);
    if (w < 4) tr_run(a, F.ws, slab ? 2 : 1, F.vcu * NWAVES + w, F.G * NWAVES, scr, lane0);
    for (int ug = F.vcu; ug < 1024; ug += F.G) {
        const int lane = lane_id_fresh(), col = lane & 31, hi = lane >> 5, tl = col >> 3, r8 = col & 7; const unsigned loff = (unsigned)lane * 16u;
        int bg, q32;
        if (F.G == 256) {
            const int xq = F.vcu >> 5, wl = F.vcu & 31, a = wl >> 1, k = ug >> 8; bg = 2 * xq + (wl & 1);
            q32 = (k == 0) ? ((w < 4) ? a : 15 - a) : (k == 1) ? 16 + a : (k == 2) ? 47 - a : 63 - a; }
        else { bg = ug & 15; q32 = ug >> 4; }
        const int b = bg >> 1, g = bg & 1;
        const int s0 = q32 * 32 + w * 4, stok = s0 + tl, h = g * 8 + r8, qblk = s0 >> 6;
        const size_t row = (size_t)b * SEQ + stok;
        const LAS float* lut_h = lut + h * LSTR + LOFF; const float c31 = lut_h[127];
        bf16x8 qr[4];
#pragma unroll
        for (int d0 = 0; d0 < 4; ++d0) qr[d0] = *(const bf16x8*)(KVQ + row * NKVQ + QCOL + h * 64 + d0 * 16 + hi * 8);
        float gl0, gl1, gl2;
        if (slab) { const float* gs = (const float*)(F.ws + WS_GS) + row * 64 + h; gl0 = 0.f; gl1 = 0.f; gl2 = 0.f;
#pragma unroll
            for (int ks = 0; ks < 4; ++ks) { gl0 += gs[(size_t)ks * M * 64]; gl1 += gs[(size_t)ks * M * 64 + 16]; gl2 += gs[(size_t)ks * M * 64 + 32]; } }
        else { gl0 = bf1(KVQ[row * NKVQ + GCOL + h]); gl1 = bf1(KVQ[row * NKVQ + GCOL + 16 + h]); gl2 = bf1(KVQ[row * NKVQ + GCOL + 32 + h]); }
        const float g_cmp = sigmoidf_(gl0), g_slc = sigmoidf_(gl1), g_win = sigmoidf_(gl2);
        LAS float* ost = (LAS float*)scr + lane;
        unsigned sel;
        {
            KVF ct[4];
#pragma unroll
            for (int kt = 0; kt < 4; ++kt) load_k(ct[kt], (const char*)KC + ((size_t)bg * 4 + kt) * 4096, loff);
            f32x16 sc[4];
#pragma unroll
            for (int kt = 0; kt < 4; ++kt) sc[kt] = attn_qk(ct[kt], qr, 0.f);
            float mx = -1e30f;
#pragma unroll
            for (int kt = 0; kt < 4; ++kt) {
                float bias[16];
#pragma unroll
                for (int r = 0; r < 16; ++r) { const int c = 32 * kt + crow(r, hi), dist = stok - (16 * c + 31); const int idx = dist < 0 ? 0 : (dist > 127 ? 127 : dist); bias[r] = lut_h[idx]; }
#pragma unroll
                for (int r = 0; r < 16; ++r) { const int c = 32 * kt + crow(r, hi), dist = stok - (16 * c + 31);
                    const float sb = sc[kt][r] + bias[r]; const float v = (dist >= 0) ? sb : -1e30f; sc[kt][r] = v; mx = fmaxf(mx, v); }
                asm volatile("" ::: "memory");
            }
            mx = fmaxf(mx, __shfl_xor(mx, 32));
            float ls = 0.f;
#pragma unroll
            for (int kt = 0; kt < 4; ++kt)
#pragma unroll
                for (int r = 0; r < 16; ++r) { const float p = (sc[kt][r] > -1e29f) ? ex2(sc[kt][r] - mx) : 0.f; sc[kt][r] = p; ls += p; }
            ls += __shfl_xor(ls, 32);
            const float inv = ls > 0.f ? 1.0f / ls : 0.f;
#pragma unroll
            for (int kt = 0; kt < 4; ++kt)
#pragma unroll
                for (int r = 0; r < 16; ++r) sc[kt][r] *= inv;
            f32x16 out[2];
#pragma unroll
            for (int r = 0; r < 16; ++r) { out[0][r] = 0.f; out[1][r] = 0.f; }
#pragma unroll
            for (int kh = 0; kh < 2; ++kh) {
                load_v(ct[2 * kh], (const char*)VTC + ((size_t)bg * 4 + 2 * kh) * 4096, loff); load_v(ct[2 * kh + 1], (const char*)VTC + ((size_t)bg * 4 + 2 * kh + 1) * 4096, loff);
                attn_pv(sc[2 * kh], out, ct[2 * kh]); attn_pv(sc[2 * kh + 1], out, ct[2 * kh + 1]);
                asm volatile("" ::: "memory"); }
#pragma unroll
            for (int dt = 0; dt < 2; ++dt)
#pragma unroll
                for (int r = 0; r < 16; ++r) ost[(dt * 16 + r) * 64] = out[dt][r] * g_cmp;
            asm volatile("" ::: "memory");
            if (qblk < 8) sel = (2u << qblk) - 1u;
            else {
                float g4[16], lastv[16], lp[16]; unsigned key[16];
#pragma unroll
                for (int kt = 0; kt < 4; ++kt)
#pragma unroll
                    for (int q4 = 0; q4 < 4; ++q4) { g4[kt * 4 + q4] = (sc[kt][4 * q4] + sc[kt][4 * q4 + 1]) + (sc[kt][4 * q4 + 2] + sc[kt][4 * q4 + 3]); lastv[kt * 4 + q4] = sc[kt][4 * q4 + 3]; }
#pragma unroll
                for (int i = 0; i < 16; ++i) { g4[i] = sum8_dpp(g4[i]); lastv[i] = sum8_dpp(lastv[i]); }
#pragma unroll
                for (int i = 0; i < 16; ++i) lp[i] = __shfl_xor(lastv[i], 32);
#pragma unroll
                for (int i = 0; i < 16; ++i) { const int j = 2 * i + hi; const float prev = hi ? lp[i] : (i > 0 ? lp[i > 0 ? i - 1 : 0] : 0.f); const float imp = g4[i] + prev;
                    key[i] = (j >= 1 && j <= qblk - 2) ? ((__builtin_bit_cast(unsigned, imp) & ~31u) | (unsigned)(31 - j)) : 0u; }
                sel = 1u | (1u << qblk) | (1u << (qblk - 1));
#pragma unroll
                for (int it = 0; it < 5; ++it) { unsigned lm = key[0];
#pragma unroll
                    for (int i = 1; i < 16; ++i) lm = lm > key[i] ? lm : key[i];
                    const unsigned pm = __shfl_xor(lm, 32), gm = lm > pm ? lm : pm;
                    sel |= 1u << (31 - (gm & 31u));
#pragma unroll
                    for (int i = 0; i < 16; ++i) key[i] = (key[i] == gm) ? 0u : key[i]; }
            }
        }
        {
            const unsigned U = (unsigned)__builtin_amdgcn_readlane((int)sel, 0) | (unsigned)__builtin_amdgcn_readlane((int)sel, 8) | (unsigned)__builtin_amdgcn_readlane((int)sel, 16) | (unsigned)__builtin_amdgcn_readlane((int)sel, 24);
            unsigned long long x = U;
            x = (x | (x << 16)) & 0x0000FFFF0000FFFFull; x = (x | (x << 8)) & 0x00FF00FF00FF00FFull; x = (x | (x << 4)) & 0x0F0F0F0F0F0F0F0Full; x = (x | (x << 2)) & 0x3333333333333333ull; x = (x | (x << 1)) & 0x5555555555555555ull;
            const unsigned long long TM = (x | (x << 1)) & ((2ull << ((s0 + 3) >> 5)) - 1ull);
            attn_branch<0>(TM, (const char*)KFS + (size_t)bg * 64 * 4096, (const char*)VTS + (size_t)bg * 64 * 4096, loff, qr, ost, g_slc, sel, s0, stok, hi, lut_h, c31);
        }
        {
            const int tthi = s0 >> 5; int ttlo = (s0 - 511 - 31 + 31) >> 5; if (s0 - 511 - 31 < 0) ttlo = 0;
            const unsigned long long TM = ((2ull << tthi) - 1ull) & ~((1ull << ttlo) - 1ull);
            attn_branch<1>(TM, (const char*)KFW + (size_t)bg * 64 * 4096, (const char*)VTW + (size_t)bg * 64 * 4096, loff, qr, ost, g_win, sel, s0, stok, hi, lut_h, c31);
        }
#pragma unroll
        for (int dt = 0; dt < 2; ++dt)
#pragma unroll
            for (int q4 = 0; q4 < 4; ++q4) { const int rb = (dt * 16 + 4 * q4) * 64; u32x2 wv; wv.x = pk2(ost[rb], ost[rb + 64]); wv.y = pk2(ost[rb + 128], ost[rb + 192]);
                *(u32x2*)(O + row * DM + h * 64 + dt * 32 + 8 * q4 + 4 * hi) = wv; }
    }
    if (w >= 4) tr_run(a, F.ws, slab ? 2 : 1, F.vcu * NWAVES + w, F.G * NWAVES, scr, lane_id_fresh());
}

__device__ __forceinline__ void route_phase(Frame& F, KArgs a, int l2, int layer, const bf16_t* xbcur) {
    const float* wr = a->in[28] + (size_t)l2 * 1024 * 8; const float* gain = a->in[3] + (size_t)layer * 1024;
    unsigned* cnt = F.ctl + CW_CNT + l2 * 8 * 64;
    int* tok_slot = (int*)(F.ws + WS_RT); float* slot_rs = (float*)(F.ws + WS_RT + 256 * 1024); float* slot_c = (float*)(F.ws + WS_RT + 768 * 1024);
    bf16_t* XG = (bf16_t*)(F.ws + WS_XG);
    LAS int* re = (LAS int*)(F.lds + RING_OFF);
    LAS float* rw = (LAS float*)(F.lds + RING_OFF + 512);
    LAS float* rrs = (LAS float*)(F.lds + RING_OFF + 1024);
    LAS int* cwv = (LAS int*)(F.lds + RING_OFF + 1280);
    LAS int* basel = (LAS int*)(F.lds + RING_OFF + 1344);
    LAS int* sl = (LAS int*)(F.lds + RING_OFF + 1408);
    const int lane = F.lane, w = F.wave;
    for (int grp = opaque_s((int)blockIdx.x); grp < M / 64; grp += F.G) {
        __syncthreads();
        for (int jh = 0; jh < 2; ++jh) {
            u32x2 xq[4][4];
#pragma unroll
            for (int q = 0; q < 4; ++q)
#pragma unroll
                for (int jj = 0; jj < 4; ++jj) xq[q][jj] = ((const u32x2*)(xbcur + (size_t)(grp * 64 + w * 8 + jh * 4 + q) * DM) + lane)[64 * jj];
#pragma unroll
            for (int q = 0; q < 4; ++q) {
            const int tl = w * 8 + jh * 4 + q; const f32x4* gr = (const f32x4*)gain + lane;
            float ss = 0.f, lg[8] = {0.f, 0.f, 0.f, 0.f, 0.f, 0.f, 0.f, 0.f};
#pragma unroll
            for (int jj = 0; jj < 4; ++jj) { const u32x2 xw = xq[q][jj]; const f32x4 v = {bflo(xw.x), bfhi(xw.x), bflo(xw.y), bfhi(xw.y)}, gg = gr[64 * jj]; ss += (v[0] * v[0] + v[1] * v[1]) + (v[2] * v[2] + v[3] * v[3]);
#pragma unroll
                for (int e4 = 0; e4 < 4; ++e4) { const float xg = v[e4] * gg[e4]; const f32x4* wp = (const f32x4*)(wr + (size_t)(256 * jj + 4 * lane + e4) * 8); const f32x4 w0 = wp[0], w1 = wp[1];
                    lg[0] += xg * w0[0]; lg[1] += xg * w0[1]; lg[2] += xg * w0[2]; lg[3] += xg * w0[3]; lg[4] += xg * w1[0]; lg[5] += xg * w1[1]; lg[6] += xg * w1[2]; lg[7] += xg * w1[3]; } }
            ss = wave_sum(ss);
#pragma unroll
            for (int e = 0; e < 8; ++e) lg[e] = wave_sum(lg[e]);
            const float rstd = __builtin_amdgcn_rsqf(ss * (1.0f / 1024.0f) + EPS);
            int e1 = 0; float v1 = lg[0];
#pragma unroll
            for (int e = 1; e < 8; ++e) if (lg[e] > v1) { v1 = lg[e]; e1 = e; }
            int e2 = -1; float v2 = -3.0e38f;
#pragma unroll
            for (int e = 0; e < 8; ++e) if (e != e1 && lg[e] > v2) { v2 = lg[e]; e2 = e; }
            const float ex = __expf((v2 - v1) * rstd), w1 = 1.0f / (1.0f + ex), w2 = ex * w1;
            if (lane == 0) { re[tl * 2] = e1; re[tl * 2 + 1] = e2; rw[tl * 2] = w1; rw[tl * 2 + 1] = w2; rrs[tl] = rstd; }
            }
        }
        __syncthreads();
        int myrank = 0, mye = 0;
        if (F.tid < 128) { mye = re[F.tid];
#pragma unroll
            for (int e = 0; e < 8; ++e) { const unsigned long long mk = __ballot(mye == e); if (mye == e) myrank = __popcll(mk & ((1ull << lane) - 1ull)); if (lane == 0) cwv[w * 8 + e] = __popcll(mk); } }
        __syncthreads();
        if (F.tid < 8) basel[F.tid] = (int)__hip_atomic_fetch_add(cnt + F.tid * 64, (unsigned)(cwv[F.tid] + cwv[8 + F.tid]), __ATOMIC_RELAXED, __HIP_MEMORY_SCOPE_AGENT);
        __syncthreads();
        if (F.tid < 128) { const int tl = F.tid >> 1, t = grp * 64 + tl; const int pos = basel[mye] + (w == 1 ? cwv[mye] : 0) + myrank; const int slot = mye * M + pos;
            tok_slot[t * 2 + (F.tid & 1)] = slot; slot_c[t * 2 + (F.tid & 1)] = rw[F.tid]; sl[F.tid] = slot; }
        __syncthreads();
        for (int i = w * 16; i < w * 16 + 16; ++i) { const int t = grp * 64 + (i >> 1); const int slot = sl[i]; const float rn = rrs[i >> 1];
#pragma unroll
            for (int hh = 0; hh < 2; ++hh) { const u32x4 v = *((const u32x4*)(xbcur + (size_t)t * DM) + lane + 64 * hh);
                u32x2 o; int t0 = __builtin_amdgcn_cvt_pk_fp8_f32(bflo(v.x) * rn, bfhi(v.x) * rn, 0, false); t0 = __builtin_amdgcn_cvt_pk_fp8_f32(bflo(v.y) * rn, bfhi(v.y) * rn, t0, true);
                int t1 = __builtin_amdgcn_cvt_pk_fp8_f32(bflo(v.z) * rn, bfhi(v.z) * rn, 0, false); t1 = __builtin_amdgcn_cvt_pk_fp8_f32(bflo(v.w) * rn, bfhi(v.w) * rn, t1, true); o.x = (unsigned)t0; o.y = (unsigned)t1;
                *((u32x2*)((unsigned char*)XG + (size_t)slot * DM) + lane + 64 * hh) = o; } }
    }
}
__device__ __forceinline__ void moe_table(Frame& F, int l2, int nN, int xown) {
    LAS int* tb = (LAS int*)(F.MISC + 16);
    __syncthreads();
    if (F.tid == 0) { const unsigned* cnt = F.ctl + CW_CNT + l2 * 8 * 64; int seg = 0, cum = 0; const int x = (int)blockIdx.x & 7;
        for (int e = 0; e < 8; ++e) { const int n = (int)__hip_atomic_load(cnt + e * 64, __ATOMIC_RELAXED, __HIP_MEMORY_SCOPE_AGENT); const int te = (n + 255) >> 8;
            const int ncol = xown ? ((((x + e) & 7) < (nN & 7)) ? (nN >> 3) + 1 : (nN >> 3)) : nN;
            tb[e] = te; tb[8 + e] = seg; tb[16 + e] = cum; seg += te * 256; cum += te * ncol; }
        tb[24] = cum; }
    __syncthreads();
}
__device__ __forceinline__ void combine_phase(Frame& F, const bf16_t* xbc, bf16_t* xbn, float* ssn) {
    const bf16_t* YM = (const bf16_t*)(F.ws + WS_YM); const int* tok_slot = (const int*)(F.ws + WS_RT); const float* tok_w = (const float*)(F.ws + WS_RT + 768 * 1024);
    const LAS int* tb = (const LAS int*)(F.MISC + 16);
    const int gw = F.vcu * NWAVES + F.wave, NGW = F.G * NWAVES;
    for (int t0 = gw * 4; t0 < M; t0 += NGW * 4) {
        int s1[4], s2[4]; float c1[4], c2[4];
#pragma unroll
        for (int q = 0; q < 4; ++q) { s1[q] = tok_slot[(t0 + q) * 2]; s2[q] = tok_slot[(t0 + q) * 2 + 1]; c1[q] = tok_w[(t0 + q) * 2]; c2[q] = tok_w[(t0 + q) * 2 + 1]; }
        u32x2 xw[4][4], a1[4][4], a2[4][4];
#pragma unroll
        for (int q = 0; q < 4; ++q) { const size_t r1 = (size_t)tb[8 + (s1[q] >> 14)] + (s1[q] & (M - 1)), r2 = (size_t)tb[8 + (s2[q] >> 14)] + (s2[q] & (M - 1));
#pragma unroll
            for (int j = 0; j < 4; ++j) { xw[q][j] = ((const u32x2*)(xbc + (size_t)(t0 + q) * DM) + F.lane)[64 * j]; a1[q][j] = ((const u32x2*)(YM + r1 * DM) + F.lane)[64 * j]; a2[q][j] = ((const u32x2*)(YM + r2 * DM) + F.lane)[64 * j]; } }
#pragma unroll
        for (int q = 0; q < 4; ++q) { u32x2* o8 = (u32x2*)(xbn + (size_t)(t0 + q) * DM) + F.lane; float s = 0.f;
#pragma unroll
            for (int j = 0; j < 4; ++j) { f32x4 v;
                v[0] = bflo(xw[q][j].x) + c1[q] * bflo(a1[q][j].x) + c2[q] * bflo(a2[q][j].x); v[1] = bfhi(xw[q][j].x) + c1[q] * bfhi(a1[q][j].x) + c2[q] * bfhi(a2[q][j].x);
                v[2] = bflo(xw[q][j].y) + c1[q] * bflo(a1[q][j].y) + c2[q] * bflo(a2[q][j].y); v[3] = bfhi(xw[q][j].y) + c1[q] * bfhi(a1[q][j].y) + c2[q] * bfhi(a2[q][j].y);
                u32x2 wv; wv.x = pk2(v[0], v[1]); wv.y = pk2(v[2], v[3]); o8[64 * j] = wv; s += (v[0] * v[0] + v[1] * v[1]) + (v[2] * v[2] + v[3] * v[3]); }
            s = wave_sum(s);
            if (F.lane < 16) ssn[(size_t)(t0 + q) * 16 + F.lane] = (F.lane == 0) ? s : 0.f; }
    }
}
__device__ __forceinline__ void vtrans_phase(Frame& F) {
    const bf16_t* KVQ = (const bf16_t*)(F.ws + WS_GXK);
    const int gw = F.vcu * NWAVES + F.wave, NGW = F.G * NWAVES, lane = F.lane, l31 = lane & 31, hi = lane >> 5;
    for (int it = gw; it < 2048; it += NGW) {
        const int which = it >> 10, bg = (it >> 6) & 15, tt = it & 63, b = bg >> 1, g = bg & 1;
        const bf16_t* src = KVQ + ((size_t)b * SEQ + tt * 32) * NKVQ + g * 64;
        bf16_t* KF = (bf16_t*)(F.ws + (which ? WS_KFW : WS_KFS)) + ((size_t)bg * 64 + tt) * 2048 + lane * 8;
        bf16_t* VF = (bf16_t*)(F.ws + (which ? WS_VTW : WS_VTS)) + ((size_t)bg * 64 + tt) * 2048 + lane * 8;
        const int kcol = which ? 512 : 256, vcol = which ? 640 : 384;
        u32x4 kv[4];
#pragma unroll
        for (int d0 = 0; d0 < 4; ++d0) kv[d0] = *(const u32x4*)(src + (size_t)l31 * NKVQ + kcol + d0 * 16 + hi * 8);
#pragma unroll
        for (int dt = 0; dt < 2; ++dt)
#pragma unroll
            for (int s2 = 0; s2 < 2; ++s2) { unsigned short e8[8];
#pragma unroll
                for (int e = 0; e < 8; ++e) e8[e] = src[(size_t)(16 * s2 + 8 * (e >> 2) + 4 * hi + (e & 3)) * NKVQ + vcol + dt * 32 + l31];
                u32x4 o; o.x = e8[0] | ((unsigned)e8[1] << 16); o.y = e8[2] | ((unsigned)e8[3] << 16); o.z = e8[4] | ((unsigned)e8[5] << 16); o.w = e8[6] | ((unsigned)e8[7] << 16);
                *(u32x4*)(VF + (dt * 2 + s2) * 512) = o; }
#pragma unroll
        for (int d0 = 0; d0 < 4; ++d0) *(u32x4*)(KF + d0 * 512) = kv[d0];
    }
}
__device__ __forceinline__ void cmp2_phase(Frame& F, KArgs a) {
    const float* HP = (const float*)(F.ws + WS_H); const float* cbias = (const float*)(F.ws + WS_SMALL); bf16_t* KC = (bf16_t*)(F.ws + WS_KC); bf16_t* VTC = KC + 16 * 128 * 64;
    LAS float* hid = (LAS float*)(F.lds + RING_OFF);
    for (int grp = opaque_s((int)blockIdx.x); grp < 256; grp += F.G) {
        const int kv = grp >> 7, row0 = (grp & 127) * 16;
        __syncthreads();
#pragma unroll
        for (int i = 0; i < 2; ++i) { const int idx = F.tid + i * 512, rl = idx >> 6, j4 = (idx & 63) * 4;
            f32x4 sacc = *(const f32x4*)(cbias + kv * 256 + j4);
#pragma unroll
            for (int ks = 0; ks < 8; ++ks) sacc += *(const f32x4*)(HP + ((size_t)(ks * 2 + kv) * 2048 + row0 + rl) * 256 + j4);
#pragma unroll
            for (int e = 0; e < 4; ++e) sacc[e] = gelu_tanh(sacc[e]);
            *(LAS f32x4*)(hid + rl * 256 + j4) = sacc; }
        __syncthreads();
        const float* w2 = a->in[kv ? 22 : 20];
#pragma unroll
        for (int i = 0; i < 2; ++i) { const int idx = F.tid + i * 512, rl = idx >> 6, d = idx & 63, rowi = row0 + rl, c = rowi & 127, bg = rowi >> 7;
            float s = 0.f;
#pragma unroll 8
            for (int j = 0; j < 256; ++j) s += hid[rl * 256 + j] * w2[(size_t)j * 64 + d];
            if (c == 127) s = 0.f;
            const int kt = c >> 5, k = c & 31;
            if (kv == 0) KC[(((size_t)bg * 4 + kt) * 4 + (d >> 4)) * 512 + ((((d >> 3) & 1) * 32) + k) * 8 + (d & 7)] = (bf16_t)f2bf(s);
            else { const int s2 = k >> 4, kk = k & 15; VTC[((((size_t)bg * 4 + kt) * 2 + (d >> 5)) * 2 + s2) * 512 + ((((kk >> 2) & 1) * 32) + (d & 31)) * 8 + 4 * (kk >> 3) + (kk & 3)] = (bf16_t)f2bf(s); } }
    }
}
__device__ __forceinline__ void quant_phase(Frame& F, KArgs a, int ld, const bf16_t* xbc) {
    unsigned* XQ = (unsigned*)(F.ws + WS_XQ); float* rowf = (float*)(F.ws + WS_ROWF);
    const int gw = F.vcu * NWAVES + F.wave, NGW = F.G * NWAVES;
    for (int m0 = gw * 4; m0 < M; m0 += NGW * 4) {
        u32x2 xw[4][4];
#pragma unroll
        for (int q = 0; q < 4; ++q)
#pragma unroll
            for (int j = 0; j < 4; ++j) xw[q][j] = ((const u32x2*)(xbc + (size_t)(m0 + q) * DM) + F.lane)[64 * j];
#pragma unroll
        for (int q = 0; q < 4; ++q) { f32x4 v[4]; float s = 0.f, mx = 0.f;
#pragma unroll
            for (int j = 0; j < 4; ++j) { v[j] = (f32x4){bflo(xw[q][j].x), bfhi(xw[q][j].x), bflo(xw[q][j].y), bfhi(xw[q][j].y)}; s += (v[j][0] * v[j][0] + v[j][1] * v[j][1]) + (v[j][2] * v[j][2] + v[j][3] * v[j][3]);
                mx = fmaxf(mx, fmaxf(fmaxf(fabsf(v[j][0]), fabsf(v[j][1])), fmaxf(fabsf(v[j][2]), fabsf(v[j][3])))); }
            s = wave_sum(s);
            mx = wave_max_nonneg(mx);
            const float rstd = __builtin_amdgcn_rsqf(s * (1.0f / 1024.0f) + EPS), qsc = mx > 0.f ? 127.0f / mx : 0.f;
#pragma unroll
            for (int j = 0; j < 4; ++j) { const int q0 = (int)__builtin_rintf(v[j][0] * qsc), q1 = (int)__builtin_rintf(v[j][1] * qsc), q2 = (int)__builtin_rintf(v[j][2] * qsc), q3 = (int)__builtin_rintf(v[j][3] * qsc);
                (XQ + (size_t)(m0 + q) * (DM / 4) + F.lane)[64 * j] = (unsigned)(q0 & 0xFF) | ((unsigned)(q1 & 0xFF) << 8) | ((unsigned)(q2 & 0xFF) << 16) | ((unsigned)(q3 & 0xFF) << 24); }
            if (F.lane == 0) rowf[m0 + q] = mx * rstd * (1.0f / 127.0f); }
    }
    LAS unsigned* scr = (LAS unsigned*)(F.lds + RING_OFF + F.wave * 16384);
    tr_run(a, F.ws, 3 + ld, gw, NGW, scr, F.lane);
}
__device__ __forceinline__ void final_phase(Frame& F, KArgs a, const bf16_t* xbc) {
    const float* gf = a->in[5];
    const int gw = F.vcu * NWAVES + F.wave, NGW = F.G * NWAVES;
    for (int m0 = gw * 4; m0 < M; m0 += NGW * 4) {
        u32x2 xw[4][4];
#pragma unroll
        for (int q = 0; q < 4; ++q)
#pragma unroll
            for (int j = 0; j < 4; ++j) xw[q][j] = ((const u32x2*)(xbc + (size_t)(m0 + q) * DM) + F.lane)[64 * j];
#pragma unroll
        for (int q = 0; q < 4; ++q) { f32x4 v[4]; float s = 0.f; f32x4* orow = (f32x4*)(a->out + (size_t)(m0 + q) * DM) + F.lane; const f32x4* gr = (const f32x4*)gf + F.lane;
#pragma unroll
            for (int j = 0; j < 4; ++j) { v[j] = (f32x4){bflo(xw[q][j].x), bfhi(xw[q][j].x), bflo(xw[q][j].y), bfhi(xw[q][j].y)}; s += (v[j][0] * v[j][0] + v[j][1] * v[j][1]) + (v[j][2] * v[j][2] + v[j][3] * v[j][3]); }
            const float rstd = __builtin_amdgcn_rsqf(wave_sum(s) * (1.0f / 1024.0f) + EPS);
#pragma unroll
            for (int j = 0; j < 4; ++j) orow[64 * j] = v[j] * rstd * gr[64 * j]; }
    }
}
#ifndef MK_PER_PHASE
#define MK_PER_PHASE 0
#endif
#ifndef MK_KMASK
#define MK_KMASK 0xFFFFFFFFu
#endif
#define KIND(k) ((MK_KMASK >> (k)) & 1u)

constexpr int N_PHASES = 34;
#ifndef MK_NOINLINE
#define PHFN static __device__ __forceinline__ void
#else
#define PHFN static __device__ __attribute__((noinline)) void
#endif
#define XBV(k) ((bf16_t*)(ws + ((k) ? WS_XB1 : WS_XB0)))
#define SSV(k) ((float*)(ws + ((k) ? WS_SS1 : WS_SS0)))
#define WSP(T, off) ((T*)(ws + (off)))
#define GEO1K pg8::Geo{1024, 2048u, 2048u, 128u, 128u, (size_t)128 * 2048, (size_t)128 * 2048}
__device__ __forceinline__ Frame mk_frame(LAS unsigned char* lds, unsigned char* ws, int wv) {
    Frame F; F.lds = lds; F.MISC = (volatile LAS unsigned*)(lds + MISC_OFF);
    F.wave = opaque_s(wv); F.lane = opaque_v(lane_id()); F.tid = F.wave * 64 + F.lane;
    F.G = opaque_s((int)gridDim.x); { const int bx = opaque_s((int)blockIdx.x); F.vcu = (F.G % 8 == 0) ? (bx % 8) * (F.G / 8) + bx / 8 : bx; }
    F.ws = ws; F.ctl = (unsigned*)(ws + WS_CTL); return F;
}
PHFN ph_prologue(LAS unsigned char* lds, unsigned char* ws, int wv, KArgs kap) { Frame F = mk_frame(lds, ws, wv); p0_prologue(F, kap); }
__device__ __forceinline__ void pp_units(LAS unsigned char* lds, unsigned char* ws, int wv, int l0, int nl, int wg0) {
    const pg8::Geo g{256, 512u, 512u, 128u, 128u, (size_t)128 * 512, (size_t)128 * 512};
    pg8::StdOrder S{(const char*)(ws + WS_PB) + (size_t)l0 * M * 512, (const char*)(ws + WS_WPP) + (size_t)l0 * 1024 * 256 * 2, (size_t)256 * 512, (size_t)256 * 512, 64 * nl, 4, 256 * nl,
                    opaque_s((int)gridDim.x) - wg0, opaque_s((int)blockIdx.x) - wg0, l0 * M, 0, 256, 64, (size_t)1024 * 256 * 2, 0, 0, 0, 0};
    pg8::EpiAct E{WSP(bf16_t, WS_PP), 1024, nullptr, 1.0f};
    pg8::gemm_phase(lds + RING_OFF, g, S, E, wv);
}
PHFN ph_win(LAS unsigned char* lds, unsigned char* ws, int wv, int L, int v) {
    pg8::StdOrder S{(const char*)XBV(v), (const char*)(ws + WS_WIN) + (size_t)L * 2048 * 1024 * 2, (size_t)256 * 2048, (size_t)256 * 2048, 64, 8, 512, opaque_s((int)gridDim.x), opaque_s((int)blockIdx.x), 0, 0, 256, 0, 0, 0, 4, 0, 0};
    pg8::EpiAct E{WSP(bf16_t, WS_GXK), 2048, SSV(v), 1.0f};
    pg8::gemm_phase(lds + RING_OFF, GEO1K, S, E, wv);
    if (L == 0) pp_units(lds, ws, wv, 0, 1, 0);
}
PHFN ph_rg(LAS unsigned char* lds, unsigned char* ws, int wv, KArgs kap, int L) { Frame F = mk_frame(lds, ws, wv); rg_phase(F, kap, L); }
PHFN ph_resid(LAS unsigned char* lds, unsigned char* ws, int wv, const float* x32, size_t a_off, size_t b_off, int K, int v) {
    const pg8::Geo g{K, (unsigned)K * 2u, (unsigned)K * 2u, 128u, 128u, (size_t)128 * K * 2, (size_t)128 * K * 2};
    pg8::StdOrder S{(const char*)(ws + a_off), (const char*)(ws + b_off), (size_t)256 * K * 2, (size_t)256 * K * 2, 64, 4, 256, opaque_s((int)gridDim.x), opaque_s((int)blockIdx.x), 0, 0, 256, 0, 0, 0, 0, 0, 0};
    pg8::EpiResid<0> E{x32, XBV(v), XBV(v ^ 1), SSV(v ^ 1), nullptr, nullptr};
    pg8::gemm_phase(lds + RING_OFF, g, S, E, wv);
}
PHFN ph_qproj(LAS unsigned char* lds, unsigned char* ws, int wv, int L, int v) {
    const int first = (L == 2) ? 0 : 3, ntile = (L == 2) ? 8 : 4;
    pg8::StdOrder S{(const char*)XBV(v), (const char*)(ws + WS_WKVQ) + ((size_t)(L - 2) * 2048 + first * 256) * 1024 * 2, (size_t)256 * 2048, (size_t)256 * 2048, 64, ntile, 64 * ntile, opaque_s((int)gridDim.x), opaque_s((int)blockIdx.x),
                    0, first * 256, 256, 0, 0, 0, 0, 3 - first, 7 - first};
    pg8::EpiAct E{WSP(bf16_t, WS_GXK), 2048, SSV(v), 1.0f};
    pg8::gemm_phase(lds + RING_OFF, GEO1K, S, E, wv);
    if (L == 3) {
        const pg8::Geo g{256, 2048u, 2048u, 128u, 128u, (size_t)128 * 2048, (size_t)128 * 2048};
        pg8::GateOrder S2{(const char*)XBV(v), (const char*)(ws + WS_WKVQ) + ((size_t)2048 + 1792) * 1024 * 2, opaque_s((int)gridDim.x), opaque_s((int)blockIdx.x)};
        pg8::EpiGateSlab E2{WSP(float, WS_GS), SSV(v)};
        pg8::gemm_phase(lds + RING_OFF, g, S2, E2, wv);
    }
}
PHFN ph_vtrans(LAS unsigned char* lds, unsigned char* ws, int wv) { Frame F = mk_frame(lds, ws, wv); vtrans_phase(F); }
PHFN ph_cmp1(LAS unsigned char* lds, unsigned char* ws, int wv) {
    const pg8::Geo g{256, 65536u, 4096u, 4096u, 128u, (size_t)128, (size_t)128 * 4096};
    pg8::CmpOrder S{(const char*)(ws + WS_GXK), (const char*)(ws + WS_WC1), opaque_s((int)blockIdx.x)};
    pg8::EpiCmp E{WSP(float, WS_H)};
    pg8::gemm_phase(lds + RING_OFF, g, S, E, wv);
}
PHFN ph_cmp2(LAS unsigned char* lds, unsigned char* ws, int wv, KArgs kap) { Frame F = mk_frame(lds, ws, wv); cmp2_phase(F, kap); }
PHFN ph_attn(LAS unsigned char* lds, unsigned char* ws, int wv, KArgs kap, int slab) { Frame F = mk_frame(lds, ws, wv); attn_phase(F, kap, slab); }
PHFN ph_quant(LAS unsigned char* lds, unsigned char* ws, int wv, KArgs kap, int L, int v) { Frame F = mk_frame(lds, ws, wv); quant_phase(F, kap, L >> 1, XBV(v)); }
PHFN ph_gu(LAS unsigned char* lds, unsigned char* ws, int wv, int L, int v) {
    const pg8::Geo g{1024, 1024u, 1024u, 128u, 128u, (size_t)128 * 1024, (size_t)128 * 1024};
    pg8::StdOrder S{(const char*)(ws + WS_XQ), (const char*)(ws + WS_WGU) + (size_t)(L >> 1) * 6144 * 1024, (size_t)256 * 1024, (size_t)256 * 1024, 64, 24, 1536, opaque_s((int)gridDim.x), opaque_s((int)blockIdx.x), 0, 0, 128, 0, 0, 0, 0, 0, 0};
    const float wm = __builtin_bit_cast(float, __hip_atomic_load((unsigned*)ws + CW_WMAX + 64 * (L >> 1), __ATOMIC_RELAXED, __HIP_MEMORY_SCOPE_AGENT));
    pg8::EpiGatedI8 E{WSP(bf16_t, WS_H), 3072, WSP(const float, WS_ROWF), wm * (1.0f / 127.0f)};
    pg8::gemm_phase_i8(lds + RING_OFF, g, S, E, wv);
}
PHFN ph_route(LAS unsigned char* lds, unsigned char* ws, int wv, KArgs kap, int L, int v) { Frame F = mk_frame(lds, ws, wv); route_phase(F, kap, L >> 1, L, XBV(v)); }
PHFN ph_mgu(LAS unsigned char* lds, unsigned char* ws, int wv, int l2) {
    Frame F = mk_frame(lds, ws, wv); const int xown = ((int)gridDim.x % 8 == 0) ? 1 : 0; moe_table(F, l2, 28, xown);
    const pg8::Geo g{1024, 1024u, 1024u, 128u, 128u, (size_t)128 * 1024, (size_t)128 * 1024};
    pg8::MoeOrder S{(const LAS int*)(F.MISC + 16), (const char*)(ws + WS_XG), (const char*)(ws + WS_WMGU) + (size_t)l2 * 8 * 7168 * 1024, (size_t)1024, (size_t)1024, opaque_s((int)gridDim.x), opaque_s((int)blockIdx.x), 28, 7168, 128, 0, xown};
    pg8::EpiGated<1> E{WSP(bf16_t, WS_H), 3584, nullptr, (const float*)(ws + WS_RT + 256 * 1024), (const float*)(ws + WS_RT + 768 * 1024)};
    if (DUP(29)) { const pg8::Geo g0{1024, 1024u, 1024u, 0u, 0u, (size_t)128 * 1024, (size_t)128 * 1024}; pg8::gemm_phase_f8(lds + RING_OFF, g0, S, E, wv); }
    pg8::gemm_phase_f8(lds + RING_OFF, g, S, E, wv);
}
PHFN ph_mdown(LAS unsigned char* lds, unsigned char* ws, int wv, int l2) {
    Frame F = mk_frame(lds, ws, wv); moe_table(F, l2, 4, 0);
    const pg8::Geo g{3584, 3584u, 3584u, 128u, 128u, (size_t)128 * 3584, (size_t)128 * 3584};
    pg8::MoeOrder S{(const LAS int*)(F.MISC + 16), (const char*)(ws + WS_H), (const char*)(ws + WS_WMDN) + (size_t)l2 * 8 * 1024 * 3584, (size_t)3584, (size_t)3584, opaque_s((int)gridDim.x), opaque_s((int)blockIdx.x), 4, 1024, 256, 1, 0};
    pg8::EpiAct E{WSP(bf16_t, WS_YM), 1024, nullptr, 0.015625f};
    pg8::gemm_phase_f8(lds + RING_OFF, g, S, E, wv);
    { const int G_ = (int)gridDim.x, rem = ((const LAS int*)(F.MISC + 16))[24] % G_;
      if (l2 == 0) pp_units(lds, ws, wv, 1, 2, rem); else pp_units(lds, ws, wv, 3, 1, rem); }
}
PHFN ph_combine(LAS unsigned char* lds, unsigned char* ws, int wv, int l2, int v) { Frame F = mk_frame(lds, ws, wv); moe_table(F, l2, 4, 0); combine_phase(F, XBV(v), XBV(v ^ 1), SSV(v ^ 1)); }
PHFN ph_gate(LAS unsigned char* lds, unsigned char* ws, int wv, int L, int v) {
    pg8::StdOrder S{(const char*)XBV(v), (const char*)(ws + WS_WPG) + (size_t)L * 1024 * 1024 * 2, (size_t)256 * 2048, (size_t)256 * 2048, 64, 4, 256, opaque_s((int)gridDim.x), opaque_s((int)blockIdx.x), 0, 0, 256, 0, 0, 0, 0, 0, 0};
    pg8::EpiResid<1> E{nullptr, XBV(v), XBV(v ^ 1), SSV(v ^ 1), SSV(v), WSP(const bf16_t, WS_PP) + (size_t)L * M * DM};
    pg8::gemm_phase(lds + RING_OFF, GEO1K, S, E, wv);
}
PHFN ph_final(LAS unsigned char* lds, unsigned char* ws, int wv, KArgs kap, int v) { Frame F = mk_frame(lds, ws, wv); final_phase(F, kap, XBV(v)); }
PHFN ph_barrier(unsigned* barw, unsigned x, LAS unsigned* st, int wv) { XcdBarrier b; b.bar = barw; b.x = x; b.st = (volatile LAS unsigned*)st; xcd_barrier(b, wv); }

#define PH_RUN (ph >= lo && ph < hi)
#define PH_END do { if (ph >= lo && ph + 1 < hi) { ph_barrier(barw, bx, bst, wv); if (DUP(31)) ph_barrier(barw, bx, bst, wv); } ++ph; } while (0)
template <int L>
__device__ __forceinline__ void layer_body(LAS unsigned char* lds, unsigned char* ws, int wv, KArgs kap, const int lo, const int hi, int& ph, int& v, unsigned* barw, unsigned bx, LAS unsigned* bst) {
    if (L < 2) {
        if (KIND(2) && PH_RUN) { ph_win(lds, ws, wv, L, v); if (DUP(2)) ph_win(lds, ws, wv, L, v); }
        PH_END;
        if (KIND(3) && PH_RUN) { ph_rg(lds, ws, wv, kap, L); if (DUP(3)) ph_rg(lds, ws, wv, kap, L); }
        PH_END;
        if (KIND(4) && PH_RUN) { ph_resid(lds, ws, wv, L == 0 ? kap->in[0] : (const float*)nullptr, WS_YO, WS_WOUT + (size_t)L * 1024 * 1024 * 2, 1024, v);
            if (DUP(4) && L == 0) { ph_resid(lds, ws, wv, kap->in[0], WS_YO, WS_WOUT, 1024, v); ph_resid(lds, ws, wv, kap->in[0], WS_YO, WS_WOUT, 1024, v); ph_resid(lds, ws, wv, kap->in[0], WS_YO, WS_WOUT, 1024, v); ph_resid(lds, ws, wv, kap->in[0], WS_YO, WS_WOUT, 1024, v); } }
        PH_END; v ^= 1;
    } else {
        if (KIND(5) && PH_RUN) { ph_qproj(lds, ws, wv, L, v); if (DUP(5)) ph_qproj(lds, ws, wv, L, v); }
        PH_END;
        if (L == 2) {
            if (KIND(6) && PH_RUN) { ph_vtrans(lds, ws, wv); ph_cmp1(lds, ws, wv); if (DUP(6)) { ph_vtrans(lds, ws, wv); ph_cmp1(lds, ws, wv); } }
            PH_END;
            if (KIND(7) && PH_RUN) { ph_cmp2(lds, ws, wv, kap); if (DUP(7)) ph_cmp2(lds, ws, wv, kap); }
            PH_END;
        }
        if (KIND(8) && PH_RUN) { ph_attn(lds, ws, wv, kap, L == 3); if (DUP(8)) ph_attn(lds, ws, wv, kap, L == 3); }
        PH_END;
        if (KIND(9) && PH_RUN) ph_resid(lds, ws, wv, (const float*)nullptr, WS_YO, WS_WO + (size_t)(L - 2) * 1024 * 1024 * 2, 1024, v);
        PH_END; v ^= 1;
    }
    if ((L & 1) == 0) {
        if (KIND(10) && PH_RUN) ph_quant(lds, ws, wv, kap, L, v);
        PH_END;
        if (KIND(10) && PH_RUN) { ph_gu(lds, ws, wv, L, v); if (DUP(10)) ph_gu(lds, ws, wv, L, v); }
        PH_END;
        if (KIND(11) && PH_RUN) ph_resid(lds, ws, wv, (const float*)nullptr, WS_H, WS_WDN + (size_t)(L >> 1) * 1024 * 3072 * 2, 3072, v);
        PH_END; v ^= 1;
    } else {
        if (KIND(12) && PH_RUN) ph_route(lds, ws, wv, kap, L, v);
        PH_END;
        if (KIND(13) && PH_RUN) { ph_mgu(lds, ws, wv, L >> 1); if (DUP(13)) ph_mgu(lds, ws, wv, L >> 1); }
        PH_END;
        if (KIND(14) && PH_RUN) { ph_mdown(lds, ws, wv, L >> 1); if (DUP(14)) ph_mdown(lds, ws, wv, L >> 1); }
        PH_END;
        if (KIND(15) && PH_RUN) ph_combine(lds, ws, wv, L >> 1, v);
        PH_END; v ^= 1;
    }
    if (KIND(16) && PH_RUN) ph_gate(lds, ws, wv, L, v);
    PH_END; v ^= 1;
}
__global__ void __launch_bounds__(NWAVES * 64, 2) mega_fwd(Args args) {
    extern __shared__ __attribute__((aligned(16))) unsigned char lds_[];
    LAS unsigned char* lds = (LAS unsigned char*)lds_;
    KArgs kap = (KArgs)__builtin_amdgcn_kernarg_segment_ptr();
    unsigned char* ws = kap->ws;
    const int wv = __builtin_amdgcn_readfirstlane((int)threadIdx.x >> 6);
    for (int u = threadIdx.x; u < (LDS_BYTES - LDSCTL_OFF) / 4; u += NWAVES * 64) ((LAS unsigned*)(lds + LDSCTL_OFF))[u] = 0u;
    __syncthreads();
    const int lo = kap->ph_lo, hi = kap->ph_hi;
    unsigned* barw = (unsigned*)(ws + WS_CTL) + CW_BAR; LAS unsigned* bst = (LAS unsigned*)(lds + MISC_OFF) + 8; unsigned bx = 0;
    if (hi - lo > 1) { const XcdBarrier b = xcd_barrier_post(barw, (volatile LAS unsigned*)bst, wv); bx = b.x; }
    int ph = 0;
    int v = 0;
    if (KIND(0) && PH_RUN) { ph_prologue(lds, ws, wv, kap); if (DUP(0)) ph_prologue(lds, ws, wv, kap); }
    PH_END;
    layer_body<0>(lds, ws, wv, kap, lo, hi, ph, v, barw, bx, bst);
    layer_body<1>(lds, ws, wv, kap, lo, hi, ph, v, barw, bx, bst);
    layer_body<2>(lds, ws, wv, kap, lo, hi, ph, v, barw, bx, bst);
    layer_body<3>(lds, ws, wv, kap, lo, hi, ph, v, barw, bx, bst);
    if (KIND(17) && PH_RUN) { ph_final(lds, ws, wv, kap, v); if (DUP(17)) ph_final(lds, ws, wv, kap, v); }
    PH_END;
}
#undef PH_RUN
#undef PH_END

extern "C" void kernel_launch(void* const* d_in, const int* in_sizes, int n_in, void* d_out, int out_size, void* d_ws, size_t ws_size, hipStream_t stream) {
    static int grid = 0;
    if (grid == 0) {
        if (n_in != 33 || out_size != M * DM || ws_size < WS_END) { fprintf(stderr, "kernel_launch: unexpected shapes (n_in %d, out %d, ws %zu < %zu)\n", n_in, out_size, ws_size, (size_t)WS_END); grid = -1; return; }
        int dev = 0, cus = 0, per_cu = 0;
        if (hipGetDevice(&dev) != hipSuccess || hipDeviceGetAttribute(&cus, hipDeviceAttributeMultiprocessorCount, dev) != hipSuccess) { grid = -1; return; }
        if (hipFuncSetAttribute((const void*)mega_fwd, hipFuncAttributeMaxDynamicSharedMemorySize, LDS_BYTES) != hipSuccess) { fprintf(stderr, "kernel_launch: hipFuncSetAttribute failed\n"); grid = -1; return; }
        if (hipOccupancyMaxActiveBlocksPerMultiprocessor(&per_cu, (const void*)mega_fwd, NWAVES * 64, LDS_BYTES) != hipSuccess || per_cu < 1) { fprintf(stderr, "kernel_launch: occupancy query says %d\n", per_cu); }
        (void)hipGetLastError();
        grid = cus;
    }
    if (grid < 0) return;
    (void)hipMemsetAsync((char*)d_ws + WS_CTL, 0, CTL_ZERO_BYTES, stream);
    Args a{};
    for (int i = 0; i < 33; ++i) a.in[i] = (const float*)d_in[i];
    a.out = (float*)d_out; a.ws = (unsigned char*)d_ws;
#if MK_PER_PHASE
    for (int p = 0; p < N_PHASES; ++p) { a.ph_lo = p; a.ph_hi = p + 1; hipLaunchKernelGGL(mega_fwd, dim3(grid), dim3(NWAVES * 64), LDS_BYTES, stream, a); }
#else
    a.ph_lo = 0; a.ph_hi = N_PHASES;
    hipLaunchKernelGGL(mega_fwd, dim3(grid), dim3(NWAVES * 64), LDS_BYTES, stream, a);
#endif
}
```

```cpp
#include <hip/hip_runtime.h>
#include <cstdio>
#include <cstdint>

#ifndef MK_DUPMASK
#define MK_DUPMASK 0u
#endif
#define DUP(k) ((MK_DUPMASK >> (k)) & 1u)
#define GAS __attribute__((address_space(1)))
#define LAS __attribute__((address_space(3)))
typedef unsigned short bf16_t;
typedef short bf16x8 __attribute__((ext_vector_type(8)));
typedef short s16x4 __attribute__((ext_vector_type(4)));
typedef float f32x4 __attribute__((ext_vector_type(4)));
typedef float f32x2 __attribute__((ext_vector_type(2)));
typedef float f32x16 __attribute__((ext_vector_type(16)));
typedef unsigned u32x4 __attribute__((ext_vector_type(4)));
typedef unsigned u32x2 __attribute__((ext_vector_type(2)));
typedef __bf16 bf16x2_t __attribute__((ext_vector_type(2)));

constexpr int NB = 8, SEQ = 2048, DM = 1024, M = NB * SEQ;
constexpr int DFF = 3072, NEXP = 8, DFE = 3584, DPLE = 256;
constexpr int NKVQ = 2048;
constexpr int QCOL = 768, GCOL = 1792;
constexpr float EPS = 1e-6f;
constexpr float LOG2E = 1.4426950408889634f;
constexpr float QSCALE = 0.125f * LOG2E;

constexpr size_t MiB = 1u << 20;
constexpr size_t WS_CTL = 0, CTL_ZERO_BYTES = 1 * MiB;
constexpr size_t WS_WIN = 1 * MiB;
constexpr size_t WS_WOUT = WS_WIN + 8 * MiB;
constexpr size_t WS_WGU = WS_WOUT + 4 * MiB;
constexpr size_t WS_WDN = WS_WGU + 24 * MiB;
constexpr size_t WS_WMGU = WS_WDN + 12 * MiB;
constexpr size_t WS_WMDN = WS_WMGU + 224 * MiB;
constexpr size_t WS_WPG = WS_WMDN + 112 * MiB;
constexpr size_t WS_WPP = WS_WPG + 8 * MiB;
constexpr size_t WS_WKVQ = WS_WPP + 2 * MiB;
constexpr size_t WS_WO = WS_WKVQ + 8 * MiB;
constexpr size_t WS_WC1 = WS_WO + 4 * MiB;
constexpr size_t WS_SMALL = WS_WC1 + 2 * MiB;
constexpr size_t WS_X = WS_SMALL + 1 * MiB;
constexpr size_t WS_XB0 = WS_X + 64 * MiB;
constexpr size_t WS_XB1 = WS_XB0 + 32 * MiB;
constexpr size_t WS_SS0 = WS_XB1 + 32 * MiB;
constexpr size_t WS_SS1 = WS_SS0 + 1 * MiB;
constexpr size_t WS_GXK = WS_SS1 + 1 * MiB;
constexpr size_t WS_YO = WS_GXK + 65 * MiB;
constexpr size_t WS_H = WS_YO + 32 * MiB;
constexpr size_t WS_XG = WS_H + 238 * MiB;
constexpr size_t WS_YM = WS_XG + 256 * MiB;
constexpr size_t WS_PP = WS_YM + 68 * MiB;
constexpr size_t WS_PB = WS_PP + 128 * MiB;
constexpr size_t WS_HID = WS_PB + 32 * MiB;
constexpr size_t WS_KC = WS_HID + 4 * MiB;
constexpr size_t WS_VTS = WS_KC + 1 * MiB;
constexpr size_t WS_VTW = WS_VTS + 4 * MiB;
constexpr size_t WS_KFS = WS_VTW + 4 * MiB;
constexpr size_t WS_KFW = WS_KFS + 4 * MiB;
constexpr size_t WS_GS = WS_KFW + 4 * MiB;
constexpr size_t WS_XQ = WS_GS + 16 * MiB;
constexpr size_t WS_ROWF = WS_XQ + 16 * MiB;
constexpr size_t WS_RT = WS_ROWF + 1 * MiB;
constexpr size_t WS_END = WS_RT + 2 * MiB;
constexpr int CW_BAR = 4096;
constexpr int CW_CNT = 16384;
constexpr int CW_WMAX = 20480;

constexpr int RING_OFF = 0, RING_BYTES = 131072;
constexpr int LDSCTL_OFF = RING_BYTES, MISC_OFF = LDSCTL_OFF + 320;
constexpr int LDS_BYTES = 147456;
constexpr int NWAVES = 8;

#define LDS_WAIT() asm volatile("s_waitcnt lgkmcnt(0)" ::: "memory")
#define VM_WAIT() asm volatile("s_waitcnt vmcnt(0)" ::: "memory")

__device__ __forceinline__ unsigned f2bf(float f) { unsigned u = __builtin_bit_cast(unsigned, f); return (u + 0x7fffu + ((u >> 16) & 1u)) >> 16; }
__device__ __forceinline__ unsigned pk2(float lo, float hi) { f32x2 v = {lo, hi}; bf16x2_t b = __builtin_convertvector(v, bf16x2_t); return __builtin_bit_cast(unsigned, b); }
__device__ __forceinline__ float bflo(unsigned w) { return __builtin_bit_cast(float, w << 16); }
__device__ __forceinline__ float bfhi(unsigned w) { return __builtin_bit_cast(float, w & 0xffff0000u); }
__device__ __forceinline__ float bf1(bf16_t h) { return __builtin_bit_cast(float, (unsigned)h << 16); }
__device__ __forceinline__ float ex2(float x) { return __builtin_amdgcn_exp2f(x); }
__device__ __forceinline__ float rcpf_(float x) { return __builtin_amdgcn_rcpf(x); }
__device__ __forceinline__ float sigmoidf_(float x) { return rcpf_(1.0f + ex2(-x * LOG2E)); }
__device__ __forceinline__ float gelu_tanh(float v) { const float z = v * (1.5957691216057308f + 0.07135481627260025f * v * v); return v * rcpf_(1.0f + ex2(-z * LOG2E)); }
__device__ __forceinline__ float silu_(float v) { return v * rcpf_(1.0f + ex2(-v * LOG2E)); }
__device__ __forceinline__ int opaque_v(int x) { asm volatile("" : "+v"(x)); return x; }
__device__ __forceinline__ int opaque_s(int x) { asm volatile("" : "+s"(x)); return x; }
__device__ __forceinline__ int lane_id() { return (int)__builtin_amdgcn_mbcnt_hi(~0u, __builtin_amdgcn_mbcnt_lo(~0u, 0u)); }
__device__ __forceinline__ int lane_id_fresh() { int x; asm volatile("v_mbcnt_lo_u32_b32 %0, -1, 0\n\tv_mbcnt_hi_u32_b32 %0, -1, %0" : "=v"(x)); return x; }
__device__ __forceinline__ float wave_sum(float v) {
#pragma unroll
    for (int o = 1; o < 64; o <<= 1) v += __shfl_xor(v, o);
    return v;
}

namespace pg8 {
constexpr int BM = 256, BK = 64, HALF = 128, HTB = HALF * BK * 2, STAGE_BYTES = 8 * HTB;
__host__ __device__ __forceinline__ int lds_byte(int r, int c) { const int st = (r >> 4) * 2 + (c >> 5), rr = r & 15, cc = c & 31, ob = rr * 64 + cc * 2; return st * 1024 + (ob ^ (((ob >> 9) & 1) << 5)); }
__host__ __device__ __forceinline__ void stage_rc(int b, int& R, int& C) { const int st = b / 1024, sb = b % 1024, swz = sb ^ (((sb >> 9) & 1) << 5); R = (st >> 1) * 16 + swz / 64; C = (st & 1) * 32 + (swz % 64) / 2; }
__host__ __device__ __forceinline__ int perm32(int rho) { const int n = rho >> 4, i = rho & 15; return 8 * (i >> 2) + 4 * n + (i & 3); }

struct Unit { const char* a; const char* b; int orow, ocol, pn, aux; };
struct Geo { int K; unsigned lda, ldb, kstA, kstB; size_t hstA, hstB; };

typedef int v4i __attribute__((ext_vector_type(4)));
template <class Epi, class Sched>
__device__ __forceinline__ void gemm_phase(LAS unsigned char* lds, const Geo g, const Sched& S, const Epi& E, int wv) {
    const int wid = opaque_s(wv), lane = opaque_v(lane_id()), tid = wid * 64 + lane, wr = wid >> 2, wc = wid & 3, fr = lane & 15, fq = lane >> 4;
    const int K = opaque_s(g.K), nt = K / BK;
    unsigned voffA[2], voffB[2];
#pragma unroll
    for (int i = 0; i < 2; ++i) { int R, C; stage_rc(tid * 16 + i * 8192, R, C); const int Rb = (R & ~31) + perm32(R & 31);
        voffA[i] = (unsigned)R * g.lda + (unsigned)C * 2u; voffB[i] = (unsigned)Rb * g.ldb + (unsigned)C * 2u; }
    const size_t kstA = g.kstA, kstB = g.kstB, hstA = g.hstA, hstB = g.hstB;
    const unsigned ldsw = (unsigned)wid * 1024u;
    const int aoff = lds_byte(wr * 64 + fr, fq * 8), boff = lds_byte(wc * 32 + fr, fq * 8);
#define PG8_SA(b, h) (((b) * 2 + (h)) * HTB)
#define PG8_SB(b, h) ((4 + (b) * 2 + (h)) * HTB)
#define PG8_STAGE(bufoff, gbase, voff) do { _Pragma("unroll") for (int _i = 0; _i < 2; ++_i) \
        __builtin_amdgcn_global_load_lds((const unsigned*)((const char*)(gbase) + (voff)[_i]), (LAS unsigned*)(lds + (bufoff) + ldsw + _i * 8192), 16, 0, 0); } while (0)
#define PG8_LDA(dst, b, h) do { _Pragma("unroll") for (int m = 0; m < 4; ++m) _Pragma("unroll") for (int k = 0; k < 2; ++k) dst[m][k] = *(const LAS bf16x8*)(lds + PG8_SA(b, h) + aoff + m * 2048 + k * 1024); } while (0)
#define PG8_LDB(dst, b, h) do { _Pragma("unroll") for (int n = 0; n < 2; ++n) _Pragma("unroll") for (int k = 0; k < 2; ++k) dst[n][k] = *(const LAS bf16x8*)(lds + PG8_SB(b, h) + boff + n * 2048 + k * 1024); } while (0)
#define PG8_MMA(ai, bj, At, Bt) do { __builtin_amdgcn_s_setprio(1); _Pragma("unroll") for (int m = 0; m < 4; ++m) _Pragma("unroll") for (int n = 0; n < 2; ++n) _Pragma("unroll") for (int k = 0; k < 2; ++k) \
        acc[ai][bj][m][n] = __builtin_amdgcn_mfma_f32_16x16x32_bf16(Bt[n][k], At[m][k], acc[ai][bj][m][n], 0, 0, 0); __builtin_amdgcn_s_setprio(0); } while (0)
#define PG8_WAIT_V(n) asm volatile("s_waitcnt vmcnt(" #n ")" ::: "memory")
#define PG8_WAIT_L(n) asm volatile("s_waitcnt lgkmcnt(" #n ")" ::: "memory")
#define PG8_BAR __builtin_amdgcn_s_barrier()
#define PG8_SCHED __builtin_amdgcn_sched_barrier(0)
    Unit cur, nxt; int ui = 0;
    if (!S.next(0, cur)) return;
    f32x4 acc[2][2][4][2];
#pragma unroll
    for (int a = 0; a < 2; ++a)
#pragma unroll
        for (int b = 0; b < 2; ++b)
#pragma unroll
            for (int m = 0; m < 4; ++m)
#pragma unroll
                for (int n = 0; n < 2; ++n) acc[a][b][m][n] = (f32x4){0.f, 0.f, 0.f, 0.f};
    bf16x8 At[4][2], B0[2][2], B1[2][2];
    const char* cA = cur.a; const char* cB = cur.b;
    PG8_STAGE(PG8_SB(0, 0), cB, voffB); PG8_STAGE(PG8_SB(0, 1), cB + hstB, voffB); PG8_STAGE(PG8_SA(0, 0), cA, voffA); PG8_STAGE(PG8_SA(0, 1), cA + hstA, voffA);
    if (wr == 1) PG8_BAR;
    PG8_WAIT_V(2); PG8_BAR;
    PG8_STAGE(PG8_SB(1, 0), cB + kstB, voffB); PG8_STAGE(PG8_SA(1, 0), cA + kstA, voffA); PG8_STAGE(PG8_SB(1, 1), cB + hstB + kstB, voffB);
    PG8_WAIT_V(6); PG8_BAR;
    for (;;) {
        const bool has_next = S.next(ui + 1, nxt);
        const char* nA = has_next ? nxt.a : cA; const char* nB = has_next ? nxt.b : cB;
        for (int t = 0; t < nt; t += 2) {
            const bool last = (t == nt - 2);
            const char* a1 = cA + (size_t)(t + 1) * kstA;
            const char* a2 = last ? nA : cA + (size_t)(t + 2) * kstA; const char* b2 = last ? nB : cB + (size_t)(t + 2) * kstB;
            const char* a3 = a2 + kstA; const char* b3 = b2 + kstB;
            PG8_LDB(B0, 0, 0); PG8_LDB(B1, 0, 1); PG8_SCHED; PG8_LDA(At, 0, 0); PG8_STAGE(PG8_SA(1, 1), a1 + hstA, voffA);
            PG8_WAIT_V(8); PG8_WAIT_L(0); PG8_BAR; PG8_MMA(0, 0, At, B0); PG8_MMA(0, 1, At, B1); PG8_BAR; PG8_SCHED;
            PG8_LDA(At, 0, 1); PG8_STAGE(PG8_SB(0, 0), b2, voffB); PG8_STAGE(PG8_SB(0, 1), b2 + hstB, voffB); PG8_STAGE(PG8_SA(0, 0), a2, voffA);
            PG8_WAIT_V(8); PG8_WAIT_L(0); PG8_BAR; PG8_MMA(1, 0, At, B0); PG8_MMA(1, 1, At, B1); PG8_BAR; PG8_SCHED;
            PG8_LDB(B0, 1, 0); PG8_LDB(B1, 1, 1); PG8_SCHED; PG8_LDA(At, 1, 0); PG8_STAGE(PG8_SA(0, 1), a2 + hstA, voffA);
            PG8_WAIT_V(8); PG8_WAIT_L(0); PG8_BAR; PG8_MMA(0, 0, At, B0); PG8_MMA(0, 1, At, B1); PG8_BAR; PG8_SCHED;
            PG8_LDA(At, 1, 1); PG8_STAGE(PG8_SB(1, 0), b3, voffB); PG8_STAGE(PG8_SB(1, 1), b3 + hstB, voffB); PG8_STAGE(PG8_SA(1, 0), a3, voffA);
            PG8_WAIT_V(8); PG8_WAIT_L(0); PG8_BAR; PG8_MMA(1, 0, At, B0); PG8_MMA(1, 1, At, B1); PG8_BAR; PG8_SCHED;
        }
        if (wr == 0) PG8_BAR;
        E(acc, cur, wr, wc, fr, fq);
        if (!has_next) break;
#pragma unroll
        for (int a = 0; a < 2; ++a)
#pragma unroll
            for (int b = 0; b < 2; ++b)
#pragma unroll
                for (int m = 0; m < 4; ++m)
#pragma unroll
                    for (int n = 0; n < 2; ++n) acc[a][b][m][n] = (f32x4){0.f, 0.f, 0.f, 0.f};
        cur = nxt; cA = nA; cB = nB; ++ui;
        if (wr == 1) PG8_BAR;
    }
    PG8_WAIT_V(0);
    PG8_BAR;
#undef PG8_SA
#undef PG8_SB
#undef PG8_STAGE
#undef PG8_LDA
#undef PG8_LDB
#undef PG8_MMA
#undef PG8_WAIT_V
#undef PG8_WAIT_L
#undef PG8_BAR
#undef PG8_SCHED
}

template <class Epi, class Sched>
__device__ __forceinline__ void gemm_phase_i8(LAS unsigned char* lds, const Geo g, const Sched& S, const Epi& E, int wv) {
    const int wid = opaque_s(wv), lane = opaque_v(lane_id()), tid = wid * 64 + lane, wr = wid >> 2, wc = wid & 3, fr = lane & 15, fq = lane >> 4;
    const int K = opaque_s(g.K), nt = K / 128;
    unsigned voffA[2], voffB[2];
#pragma unroll
    for (int i = 0; i < 2; ++i) { int R, C; stage_rc(tid * 16 + i * 8192, R, C); const int Rb = (R & ~31) + perm32(R & 31);
        voffA[i] = (unsigned)R * g.lda + (unsigned)C * 2u; voffB[i] = (unsigned)Rb * g.ldb + (unsigned)C * 2u; }
    const size_t kstA = g.kstA, kstB = g.kstB, hstA = g.hstA, hstB = g.hstB;
    const unsigned ldsw = (unsigned)wid * 1024u;
    const int aoff = lds_byte(wr * 64 + fr, fq * 8), boff = lds_byte(wc * 32 + fr, fq * 8);
#define PG8_SA(b, h) (((b) * 2 + (h)) * HTB)
#define PG8_SB(b, h) ((4 + (b) * 2 + (h)) * HTB)
#define PG8_STAGE(bufoff, gbase, voff) do { _Pragma("unroll") for (int _i = 0; _i < 2; ++_i) \
        __builtin_amdgcn_global_load_lds((const unsigned*)((const char*)(gbase) + (voff)[_i]), (LAS unsigned*)(lds + (bufoff) + ldsw + _i * 8192), 16, 0, 0); } while (0)
#define PG8_LDA(dst, b, h) do { _Pragma("unroll") for (int m = 0; m < 4; ++m) _Pragma("unroll") for (int k = 0; k < 2; ++k) dst[m][k] = *(const LAS bf16x8*)(lds + PG8_SA(b, h) + aoff + m * 2048 + k * 1024); } while (0)
#define PG8_LDB(dst, b, h) do { _Pragma("unroll") for (int n = 0; n < 2; ++n) _Pragma("unroll") for (int k = 0; k < 2; ++k) dst[n][k] = *(const LAS bf16x8*)(lds + PG8_SB(b, h) + boff + n * 2048 + k * 1024); } while (0)
#define PG8_MMA(ai, bj, At, Bt) do { __builtin_amdgcn_s_setprio(1); _Pragma("unroll") for (int m = 0; m < 4; ++m) _Pragma("unroll") for (int n = 0; n < 2; ++n) _Pragma("unroll") for (int k = 0; k < 2; ++k) \
        acc[ai][bj][m][n] = __builtin_amdgcn_mfma_i32_16x16x64_i8(__builtin_bit_cast(v4i, Bt[n][k]), __builtin_bit_cast(v4i, At[m][k]), acc[ai][bj][m][n], 0, 0, 0); __builtin_amdgcn_s_setprio(0); } while (0)
#define PG8_WAIT_V(n) asm volatile("s_waitcnt vmcnt(" #n ")" ::: "memory")
#define PG8_WAIT_L(n) asm volatile("s_waitcnt lgkmcnt(" #n ")" ::: "memory")
#define PG8_BAR __builtin_amdgcn_s_barrier()
#define PG8_SCHED __builtin_amdgcn_sched_barrier(0)
    Unit cur, nxt; int ui = 0;
    if (!S.next(0, cur)) return;
    v4i acc[2][2][4][2];
#pragma unroll
    for (int a = 0; a < 2; ++a)
#pragma unroll
        for (int b = 0; b < 2; ++b)
#pragma unroll
            for (int m = 0; m < 4; ++m)
#pragma unroll
                for (int n = 0; n < 2; ++n) acc[a][b][m][n] = (v4i){0, 0, 0, 0};
    bf16x8 At[4][2], B0[2][2], B1[2][2];
    const char* cA = cur.a; const char* cB = cur.b;
    PG8_STAGE(PG8_SB(0, 0), cB, voffB); PG8_STAGE(PG8_SB(0, 1), cB + hstB, voffB); PG8_STAGE(PG8_SA(0, 0), cA, voffA); PG8_STAGE(PG8_SA(0, 1), cA + hstA, voffA);
    if (wr == 1) PG8_BAR;
    PG8_WAIT_V(2); PG8_BAR;
    PG8_STAGE(PG8_SB(1, 0), cB + kstB, voffB); PG8_STAGE(PG8_SA(1, 0), cA + kstA, voffA); PG8_STAGE(PG8_SB(1, 1), cB + hstB + kstB, voffB);
    PG8_WAIT_V(6); PG8_BAR;
    for (;;) {
        const bool has_next = S.next(ui + 1, nxt);
        const char* nA = has_next ? nxt.a : cA; const char* nB = has_next ? nxt.b : cB;
        for (int t = 0; t < nt; t += 2) {
            const bool last = (t == nt - 2);
            const char* a1 = cA + (size_t)(t + 1) * kstA;
            const char* a2 = last ? nA : cA + (size_t)(t + 2) * kstA; const char* b2 = last ? nB : cB + (size_t)(t + 2) * kstB;
            const char* a3 = a2 + kstA; const char* b3 = b2 + kstB;
            PG8_LDB(B0, 0, 0); PG8_LDB(B1, 0, 1); PG8_SCHED; PG8_LDA(At, 0, 0); PG8_STAGE(PG8_SA(1, 1), a1 + hstA, voffA);
            PG8_WAIT_V(8); PG8_WAIT_L(0); PG8_BAR; PG8_MMA(0, 0, At, B0); PG8_MMA(0, 1, At, B1); PG8_BAR; PG8_SCHED;
            PG8_LDA(At, 0, 1); PG8_STAGE(PG8_SB(0, 0), b2, voffB); PG8_STAGE(PG8_SB(0, 1), b2 + hstB, voffB); PG8_STAGE(PG8_SA(0, 0), a2, voffA);
            PG8_WAIT_V(8); PG8_WAIT_L(0); PG8_BAR; PG8_MMA(1, 0, At, B0); PG8_MMA(1, 1, At, B1); PG8_BAR; PG8_SCHED;
            PG8_LDB(B0, 1, 0); PG8_LDB(B1, 1, 1); PG8_SCHED; PG8_LDA(At, 1, 0); PG8_STAGE(PG8_SA(0, 1), a2 + hstA, voffA);
            PG8_WAIT_V(8); PG8_WAIT_L(0); PG8_BAR; PG8_MMA(0, 0, At, B0); PG8_MMA(0, 1, At, B1); PG8_BAR; PG8_SCHED;
            PG8_LDA(At, 1, 1); PG8_STAGE(PG8_SB(1, 0), b3, voffB); PG8_STAGE(PG8_SB(1, 1), b3 + hstB, voffB); PG8_STAGE(PG8_SA(1, 0), a3, voffA);
            PG8_WAIT_V(8); PG8_WAIT_L(0); PG8_BAR; PG8_MMA(1, 0, At, B0); PG8_MMA(1, 1, At, B1); PG8_BAR; PG8_SCHED;
        }
        if (wr == 0) PG8_BAR;
        E(acc, cur, wr, wc, fr, fq);
        if (!has_next) break;
#pragma unroll
        for (int a = 0; a < 2; ++a)
#pragma unroll
            for (int b = 0; b < 2; ++b)
#pragma unroll
                for (int m = 0; m < 4; ++m)
#pragma unroll
                    for (int n = 0; n < 2; ++n) acc[a][b][m][n] = (v4i){0, 0, 0, 0};
        cur = nxt; cA = nA; cB = nB; ++ui;
        if (wr == 1) PG8_BAR;
    }
    PG8_WAIT_V(0);
    PG8_BAR;
#undef PG8_SA
#undef PG8_SB
#undef PG8_STAGE
#undef PG8_LDA
#undef PG8_LDB
#undef PG8_MMA
#undef PG8_WAIT_V
#undef PG8_WAIT_L
#undef PG8_BAR
#undef PG8_SCHED
}

typedef int v8i __attribute__((ext_vector_type(8)));
template <class Epi, class Sched>
__device__ __forceinline__ void gemm_phase_f8(LAS unsigned char* lds, const Geo g, const Sched& S, const Epi& E, int wv) {
    const int wid = opaque_s(wv), lane = opaque_v(lane_id()), tid = wid * 64 + lane, wr = wid >> 2, wc = wid & 3, fr = lane & 15, fq = lane >> 4;
    const int K = opaque_s(g.K), nt = K / 128;
    unsigned voffA[2], voffB[2];
#pragma unroll
    for (int i = 0; i < 2; ++i) { int R, C; stage_rc(tid * 16 + i * 8192, R, C); const int Rb = (R & ~31) + perm32(R & 31);
        voffA[i] = (unsigned)R * g.lda + (unsigned)C * 2u; voffB[i] = (unsigned)Rb * g.ldb + (unsigned)C * 2u; }
    const size_t kstA = g.kstA, kstB = g.kstB, hstA = g.hstA, hstB = g.hstB;
    const unsigned ldsw = (unsigned)wid * 1024u;
    const int aoff = lds_byte(wr * 64 + fr, fq * 8), boff = lds_byte(wc * 32 + fr, fq * 8);
#define PG8_SA(b, h) (((b) * 2 + (h)) * HTB)
#define PG8_SB(b, h) ((4 + (b) * 2 + (h)) * HTB)
#define PG8_STAGE(bufoff, gbase, voff) do { _Pragma("unroll") for (int _i = 0; _i < 2; ++_i) \
        __builtin_amdgcn_global_load_lds((const unsigned*)((const char*)(gbase) + (voff)[_i]), (LAS unsigned*)(lds + (bufoff) + ldsw + _i * 8192), 16, 0, 0); } while (0)
#define PG8_LD8(p) __builtin_shufflevector(*(const LAS v4i*)(p), *(const LAS v4i*)((p) + 1024), 0, 1, 2, 3, 4, 5, 6, 7)
#define PG8_LDA(dst, b, h) do { _Pragma("unroll") for (int m = 0; m < 4; ++m) dst[m] = PG8_LD8(lds + PG8_SA(b, h) + aoff + m * 2048); } while (0)
#define PG8_LDB(dst, b, h) do { _Pragma("unroll") for (int n = 0; n < 2; ++n) dst[n] = PG8_LD8(lds + PG8_SB(b, h) + boff + n * 2048); } while (0)
#define PG8_MMA(ai, bj, At, Bt) do { __builtin_amdgcn_s_setprio(1); _Pragma("unroll") for (int m = 0; m < 4; ++m) _Pragma("unroll") for (int n = 0; n < 2; ++n) \
        asm volatile("v_mfma_f32_16x16x128_f8f6f4 %0, %1, %2, %0" : "+v"(acc[ai][bj][m][n]) : "v"(Bt[n]), "v"(At[m])); __builtin_amdgcn_s_setprio(0); } while (0)
#define PG8_WAIT_V(n) asm volatile("s_waitcnt vmcnt(" #n ")" ::: "memory")
#define PG8_WAIT_L(n) asm volatile("s_waitcnt lgkmcnt(" #n ")" ::: "memory")
#define PG8_BAR __builtin_amdgcn_s_barrier()
#define PG8_SCHED __builtin_amdgcn_sched_barrier(0)
    Unit cur, nxt; int ui = 0;
    if (!S.next(0, cur)) return;
    f32x4 acc[2][2][4][2];
#pragma unroll
    for (int a = 0; a < 2; ++a)
#pragma unroll
        for (int b = 0; b < 2; ++b)
#pragma unroll
            for (int m = 0; m < 4; ++m)
#pragma unroll
                for (int n = 0; n < 2; ++n) acc[a][b][m][n] = (f32x4){0.f, 0.f, 0.f, 0.f};
    v8i At[4], B0[2], B1[2];
    const char* cA = cur.a; const char* cB = cur.b;
    PG8_STAGE(PG8_SB(0, 0), cB, voffB); PG8_STAGE(PG8_SB(0, 1), cB + hstB, voffB); PG8_STAGE(PG8_SA(0, 0), cA, voffA); PG8_STAGE(PG8_SA(0, 1), cA + hstA, voffA);
    if (wr == 1) PG8_BAR;
    PG8_WAIT_V(2); PG8_BAR;
    PG8_STAGE(PG8_SB(1, 0), cB + kstB, voffB); PG8_STAGE(PG8_SA(1, 0), cA + kstA, voffA); PG8_STAGE(PG8_SB(1, 1), cB + hstB + kstB, voffB);
    PG8_WAIT_V(6); PG8_BAR;
    for (;;) {
        const bool has_next = S.next(ui + 1, nxt);
        const char* nA = has_next ? nxt.a : cA; const char* nB = has_next ? nxt.b : cB;
        for (int t = 0; t < nt; t += 2) {
            const bool last = (t == nt - 2);
            const char* a1 = cA + (size_t)(t + 1) * kstA;
            const char* a2 = last ? nA : cA + (size_t)(t + 2) * kstA; const char* b2 = last ? nB : cB + (size_t)(t + 2) * kstB;
            const char* a3 = a2 + kstA; const char* b3 = b2 + kstB;
            PG8_LDB(B0, 0, 0); PG8_LDB(B1, 0, 1); PG8_SCHED; PG8_LDA(At, 0, 0); PG8_STAGE(PG8_SA(1, 1), a1 + hstA, voffA);
            PG8_WAIT_V(8); PG8_WAIT_L(0); PG8_BAR; PG8_MMA(0, 0, At, B0); PG8_MMA(0, 1, At, B1); PG8_BAR; PG8_SCHED;
            PG8_LDA(At, 0, 1); PG8_STAGE(PG8_SB(0, 0), b2, voffB); PG8_STAGE(PG8_SB(0, 1), b2 + hstB, voffB); PG8_STAGE(PG8_SA(0, 0), a2, voffA);
            PG8_WAIT_V(8); PG8_WAIT_L(0); PG8_BAR; PG8_MMA(1, 0, At, B0); PG8_MMA(1, 1, At, B1); PG8_BAR; PG8_SCHED;
            PG8_LDB(B0, 1, 0); PG8_LDB(B1, 1, 1); PG8_SCHED; PG8_LDA(At, 1, 0); PG8_STAGE(PG8_SA(0, 1), a2 + hstA, voffA);
            PG8_WAIT_V(8); PG8_WAIT_L(0); PG8_BAR; PG8_MMA(0, 0, At, B0); PG8_MMA(0, 1, At, B1); PG8_BAR; PG8_SCHED;
            PG8_LDA(At, 1, 1); PG8_STAGE(PG8_SB(1, 0), b3, voffB); PG8_STAGE(PG8_SB(1, 1), b3 + hstB, voffB); PG8_STAGE(PG8_SA(1, 0), a3, voffA);
            PG8_WAIT_V(8); PG8_WAIT_L(0); PG8_BAR; PG8_MMA(1, 0, At, B0); PG8_MMA(1, 1, At, B1); PG8_BAR; PG8_SCHED;
        }
        if (wr == 0) PG8_BAR;
        asm volatile("s_nop 15\n\ts_nop 15" ::: "memory");
        E(acc, cur, wr, wc, fr, fq);
        if (DUP(30)) { asm volatile("" ::: "memory"); E(acc, cur, wr, wc, fr, fq); }
        if (!has_next) break;
#pragma unroll
        for (int a = 0; a < 2; ++a)
#pragma unroll
            for (int b = 0; b < 2; ++b)
#pragma unroll
                for (int m = 0; m < 4; ++m)
#pragma unroll
                    for (int n = 0; n < 2; ++n) acc[a][b][m][n] = (f32x4){0.f, 0.f, 0.f, 0.f};
        cur = nxt; cA = nA; cB = nB; ++ui;
        if (wr == 1) PG8_BAR;
    }
    PG8_WAIT_V(0);
    PG8_BAR;
#undef PG8_SA
#undef PG8_SB
#undef PG8_STAGE
#undef PG8_LDA
#undef PG8_LDB
#undef PG8_MMA
#undef PG8_LD8
#undef PG8_WAIT_V
#undef PG8_WAIT_L
#undef PG8_BAR
#undef PG8_SCHED
}

__device__ __forceinline__ float row_rstd(const float* ss, int row, int fq) {
    const f32x4 v = *(const f32x4*)(ss + (size_t)row * 16 + fq * 4);
    float s = (v[0] + v[1]) + (v[2] + v[3]);
    s += __shfl_xor(s, 16); s += __shfl_xor(s, 32);
    return __builtin_amdgcn_rsqf(s * (1.0f / 1024.0f) + EPS);
}
struct EpiAct {
    bf16_t* O; int ldc; const float* ss; float osc;
    __device__ __forceinline__ void operator()(const f32x4 (&acc)[2][2][4][2], const Unit& u, int wr, int wc, int fr, int fq) const {
        const bool gl = (u.aux & 1) != 0; const float sc = (u.aux & 2) ? QSCALE : 1.0f;
#pragma unroll
        for (int ai = 0; ai < 2; ++ai)
#pragma unroll
            for (int m = 0; m < 4; ++m) {
                const int row = u.orow + ai * HALF + wr * 64 + m * 16 + fr;
                const float rs = (ss ? row_rstd(ss, row, fq) : 1.0f) * sc * osc;
                bf16_t* rowp = O + (size_t)row * ldc + u.ocol + wc * 32 + 8 * fq;
#pragma unroll
                for (int bj = 0; bj < 2; ++bj) { f32x4 v0 = acc[ai][bj][m][0] * rs, v1 = acc[ai][bj][m][1] * rs;
                    if (gl) {
#pragma unroll
                        for (int e = 0; e < 4; ++e) { v0[e] = gelu_tanh(v0[e]); v1[e] = gelu_tanh(v1[e]); } }
                    u32x4 w; w.x = pk2(v0[0], v0[1]); w.y = pk2(v0[2], v0[3]); w.z = pk2(v1[0], v1[1]); w.w = pk2(v1[2], v1[3]);
                    *(u32x4*)(rowp + bj * HALF) = w; } }
    }
};
struct EpiCmp {
    float* O;
    __device__ __forceinline__ void operator()(const f32x4 (&acc)[2][2][4][2], const Unit& u, int wr, int wc, int fr, int fq) const {
        float* OO = O + (size_t)u.aux * 2048 * 256;
#pragma unroll
        for (int bj = 0; bj < 2; ++bj) { const int col = bj * HALF + wc * 32 + 8 * fq;
#pragma unroll
            for (int ai = 0; ai < 2; ++ai)
#pragma unroll
                for (int m = 0; m < 4; ++m) { const int row = u.orow + ai * HALF + wr * 64 + m * 16 + fr;
                    *(f32x4*)(OO + (size_t)row * 256 + col) = acc[ai][bj][m][0]; *(f32x4*)(OO + (size_t)row * 256 + col + 4) = acc[ai][bj][m][1]; } }
    }
};
struct EpiGateSlab {
    float* O; const float* ss;
    __device__ __forceinline__ void operator()(const f32x4 (&acc)[2][2][4][2], const Unit& u, int wr, int wc, int fr, int fq) const {
        if (wc >= 2) return;
        float* OO = O + (size_t)u.aux * M * 64;
#pragma unroll
        for (int ai = 0; ai < 2; ++ai)
#pragma unroll
            for (int m = 0; m < 4; ++m) { const int row = u.orow + ai * HALF + wr * 64 + m * 16 + fr; const float rs = row_rstd(ss, row, fq);
                *(f32x4*)(OO + (size_t)row * 64 + wc * 32 + 8 * fq) = acc[ai][0][m][0] * rs; *(f32x4*)(OO + (size_t)row * 64 + wc * 32 + 8 * fq + 4) = acc[ai][0][m][1] * rs; }
    }
};
struct GateOrder {
    const char* A; const char* Bt; int G, c;
    __device__ __forceinline__ bool next(int i, Unit& u) const {
        const int L = i * G + c; if (L >= 256) return false;
        const int pm = L & 63, ks = L >> 6;
        u.a = A + (size_t)pm * 256 * 2048 + ks * 512; u.b = Bt + ks * 512; u.orow = pm * 256; u.ocol = 0; u.pn = 0; u.aux = ks; return true;
    }
};
template <int MOE> struct EpiGated {
    bf16_t* O; int ldc; const float* ss; const float* rsA; const float* rsC;
    __device__ __forceinline__ void operator()(const f32x4 (&acc)[2][2][4][2], const Unit& u, int wr, int wc, int fr, int fq) const {
#pragma unroll
        for (int ai = 0; ai < 2; ++ai)
#pragma unroll
            for (int m = 0; m < 4; ++m) {
                const int lrow = ai * HALF + wr * 64 + m * 16 + fr, row = u.orow + lrow;
                float ra;
                if (MOE) ra = 0.015625f; else ra = row_rstd(ss, row, fq);
                const float nra = -ra * LOG2E, ira2 = MOE ? 4096.0f : 1.0f / (ra * ra);
                f32x4 h0, h1;
#pragma unroll
                for (int q = 0; q < 2; ++q) {
                    const f32x2 g0 = {acc[ai][0][m][0][2 * q], acc[ai][0][m][0][2 * q + 1]}, g1 = {acc[ai][0][m][1][2 * q], acc[ai][0][m][1][2 * q + 1]};
                    const f32x2 u0 = {acc[ai][1][m][0][2 * q], acc[ai][1][m][0][2 * q + 1]}, u1 = {acc[ai][1][m][1][2 * q], acc[ai][1][m][1][2 * q + 1]};
                    const f32x2 n2 = {nra, nra}, i2 = {ira2, ira2};
                    const f32x2 x0 = g0 * n2, x1 = g1 * n2;
                    const f32x2 e0 = {ex2(x0.x), ex2(x0.y)}, e1 = {ex2(x1.x), ex2(x1.y)};
                    const f32x2 d0 = __builtin_elementwise_fma(e0, i2, i2), d1 = __builtin_elementwise_fma(e1, i2, i2);
                    const f32x2 r0 = {rcpf_(d0.x), rcpf_(d0.y)}, r1 = {rcpf_(d1.x), rcpf_(d1.y)};
                    const f32x2 t0 = (g0 * u0) * r0, t1 = (g1 * u1) * r1;
                    h0[2 * q] = t0.x; h0[2 * q + 1] = t0.y; h1[2 * q] = t1.x; h1[2 * q + 1] = t1.y; }
                float h[8];
#pragma unroll
                for (int e = 0; e < 4; ++e) { h[e] = h0[e]; h[4 + e] = h1[e];
                    if (MOE) { h[e] = fminf(fmaxf(h[e], -448.f), 448.f); h[4 + e] = fminf(fmaxf(h[4 + e], -448.f), 448.f); } }
                if (MOE) { u32x2 w8; int t0 = __builtin_amdgcn_cvt_pk_fp8_f32(h[0], h[1], 0, false); t0 = __builtin_amdgcn_cvt_pk_fp8_f32(h[2], h[3], t0, true);
                    int t1 = __builtin_amdgcn_cvt_pk_fp8_f32(h[4], h[5], 0, false); t1 = __builtin_amdgcn_cvt_pk_fp8_f32(h[6], h[7], t1, true); w8.x = (unsigned)t0; w8.y = (unsigned)t1;
                    *(u32x2*)((unsigned char*)O + (size_t)row * ldc + u.ocol + wc * 32 + 8 * fq) = w8; }
                else { u32x4 w; w.x = pk2(h[0], h[1]); w.y = pk2(h[2], h[3]); w.z = pk2(h[4], h[5]); w.w = pk2(h[6], h[7]);
                    *(u32x4*)(O + (size_t)row * ldc + u.ocol + wc * 32 + 8 * fq) = w; } }
    }
};
struct EpiGatedI8 {
    bf16_t* O; int ldc; const float* rowf; float wsc;
    __device__ __forceinline__ void operator()(const v4i (&acc)[2][2][4][2], const Unit& u, int wr, int wc, int fr, int fq) const {
#pragma unroll
        for (int ai = 0; ai < 2; ++ai)
#pragma unroll
            for (int m = 0; m < 4; ++m) {
                const int row = u.orow + ai * HALF + wr * 64 + m * 16 + fr;
                const float rf = rowf[row] * wsc, nrf = -rf * LOG2E, irf2 = rcpf_(fmaxf(rf * rf, 1e-30f));
                f32x4 h0, h1;
#pragma unroll
                for (int q = 0; q < 2; ++q) {
                    const f32x2 g0 = {(float)acc[ai][0][m][0][2 * q], (float)acc[ai][0][m][0][2 * q + 1]}, g1 = {(float)acc[ai][0][m][1][2 * q], (float)acc[ai][0][m][1][2 * q + 1]};
                    const f32x2 u0 = {(float)acc[ai][1][m][0][2 * q], (float)acc[ai][1][m][0][2 * q + 1]}, u1 = {(float)acc[ai][1][m][1][2 * q], (float)acc[ai][1][m][1][2 * q + 1]};
                    const f32x2 n2 = {nrf, nrf}, i2 = {irf2, irf2};
                    const f32x2 x0 = g0 * n2, x1 = g1 * n2;
                    const f32x2 e0 = {ex2(x0.x), ex2(x0.y)}, e1 = {ex2(x1.x), ex2(x1.y)};
                    const f32x2 d0 = __builtin_elementwise_fma(e0, i2, i2), d1 = __builtin_elementwise_fma(e1, i2, i2);
                    const f32x2 r0 = {rcpf_(d0.x), rcpf_(d0.y)}, r1 = {rcpf_(d1.x), rcpf_(d1.y)};
                    const f32x2 t0 = (g0 * u0) * r0, t1 = (g1 * u1) * r1;
                    h0[2 * q] = t0.x; h0[2 * q + 1] = t0.y; h1[2 * q] = t1.x; h1[2 * q + 1] = t1.y; }
                float h[8];
#pragma unroll
                for (int e = 0; e < 4; ++e) { h[e] = h0[e]; h[4 + e] = h1[e]; }
                u32x4 w; w.x = pk2(h[0], h[1]); w.y = pk2(h[2], h[3]); w.z = pk2(h[4], h[5]); w.w = pk2(h[6], h[7]);
                *(u32x4*)(O + (size_t)row * ldc + u.ocol + wc * 32 + 8 * fq) = w; }
    }
};
template <int GATE> struct EpiResid {
    const float* x32; const bf16_t* xb_in; bf16_t* xb; float* ssn; const float* ss; const bf16_t* pp;
    __device__ __forceinline__ void operator()(const f32x4 (&acc)[2][2][4][2], const Unit& u, int wr, int wc, int fr, int fq) const {
#pragma unroll
        for (int ai = 0; ai < 2; ++ai)
#pragma unroll
            for (int m = 0; m < 4; ++m) {
                const int row = u.orow + ai * HALF + wr * 64 + m * 16 + fr;
                float rs = 1.0f; if (GATE) rs = -LOG2E * row_rstd(ss, row, fq);
                float sq = 0.f;
#pragma unroll
                for (int bj = 0; bj < 2; ++bj) { const size_t off = (size_t)row * DM + u.ocol + bj * HALF + wc * 32 + 8 * fq;
                    f32x4 x0, x1;
                    if (x32) { x0 = *(const f32x4*)(x32 + off); x1 = *(const f32x4*)(x32 + off + 4); }
                    else { const u32x4 xw = *(const u32x4*)(xb_in + off); x0 = (f32x4){bflo(xw.x), bfhi(xw.x), bflo(xw.y), bfhi(xw.y)}; x1 = (f32x4){bflo(xw.z), bfhi(xw.z), bflo(xw.w), bfhi(xw.w)}; }
                    f32x4 v0 = acc[ai][bj][m][0], v1 = acc[ai][bj][m][1];
                    if (GATE) { const u32x4 pw = *(const u32x4*)(pp + off);
                        const f32x4 p0 = {bflo(pw.x), bfhi(pw.x), bflo(pw.y), bfhi(pw.y)}, p1 = {bflo(pw.z), bfhi(pw.z), bflo(pw.w), bfhi(pw.w)};
#pragma unroll
                        for (int e = 0; e < 4; ++e) { v0[e] = rcpf_(1.0f + ex2(v0[e] * rs)) * p0[e]; v1[e] = rcpf_(1.0f + ex2(v1[e] * rs)) * p1[e]; } }
                    x0 += v0; x1 += v1;
                    u32x4 w; w.x = pk2(x0[0], x0[1]); w.y = pk2(x0[2], x0[3]); w.z = pk2(x1[0], x1[1]); w.w = pk2(x1[2], x1[3]);
                    *(u32x4*)(xb + off) = w;
                    sq += ((x0[0] * x0[0] + x0[1] * x0[1]) + (x0[2] * x0[2] + x0[3] * x0[3])) + ((x1[0] * x1[0] + x1[1] * x1[1]) + (x1[2] * x1[2] + x1[3] * x1[3])); }
                sq += __shfl_xor(sq, 16); sq += __shfl_xor(sq, 32);
                if (fq == 0) ssn[(size_t)row * 16 + u.pn * 4 + wc] = sq; }
    }
};

struct StdOrder {
    const char* A; const char* Bt; size_t a_tile, b_tile;
    int nM, nN, nwg, G, c; int orow0, ocol0, ocstep; int tpl; size_t b_layer;
    int f1lo, f1hi, f2lo, f2hi;
    __device__ __forceinline__ bool next(int i, Unit& u) const {
        if (c < 0) return false;
        const long L = (long)i * G + c; if (L >= nwg) return false;
        int wgid = (int)L; { const int q = nwg / 8, r = nwg % 8, xcd = wgid % 8, off = wgid / 8; wgid = (xcd < r ? xcd * (q + 1) : r * (q + 1) + (xcd - r) * q) + off; }
        const int nig = 8 * nN, gid = wgid / nig, fm = gid * 8, gsz = (nM - fm) < 8 ? (nM - fm) : 8;
        const int pm = fm + ((wgid % nig) % gsz), pn = (wgid % nig) / gsz;
        u.a = A + (size_t)pm * a_tile; u.b = Bt + (size_t)pn * b_tile + (tpl ? (size_t)(pm / tpl) * b_layer : 0);
        u.orow = orow0 + pm * BM; u.ocol = ocol0 + pn * ocstep; u.pn = pn;
        u.aux = ((pn >= f1lo && pn < f1hi) ? 1 : 0) | ((pn >= f2lo && pn < f2hi) ? 2 : 0);
        return true;
    }
};
struct CmpOrder {
    const char* kvq; const char* w1; int c;
    __device__ __forceinline__ bool next(int i, Unit& u) const {
        if (i > 0 || c >= 128) return false;
        const int kv = c >> 6, b = (c >> 3) & 7, ks = c & 7;
        u.a = kvq + ((size_t)b * SEQ * NKVQ + kv * 128) * 2 + (size_t)ks * 4 * (NKVQ * 2); u.b = w1 + (size_t)kv * 256 * 2048 * 2 + (size_t)ks * 256 * 2;
        u.orow = b * 256; u.ocol = 0; u.pn = 0; u.aux = ks * 2 + kv; return true;
    }
};
struct MoeOrder {
    const LAS int* tb; const char* A; const char* Bt; size_t a_row, b_row; int G, c, nN, bn, ocstep, a_by_seg, xown;
    __device__ __forceinline__ bool next(int i, Unit& u) const {
        const int L = xown ? i * (G >> 3) + (c >> 3) : i * G + c; if (L >= tb[24]) return false;
        int e = 0;
#pragma unroll
        for (int k = 1; k < 8; ++k) e += (L >= tb[16 + k]) ? 1 : 0;
        const int local = L - tb[16 + e], te = tb[e], rt = local % te, seg = tb[8 + e]; int pn = local / te;
        if (xown) pn = ((c + e) & 7) + 8 * pn;
        const int arow = a_by_seg ? seg + rt * BM : e * M + rt * BM;
        u.a = A + (size_t)arow * a_row; u.b = Bt + ((size_t)e * bn + (size_t)pn * BM) * b_row;
        u.orow = seg + rt * BM; u.ocol = pn * ocstep; u.pn = pn; u.aux = a_by_seg ? 0 : e * M + rt * BM; return true;
    }
};
}

typedef GAS unsigned gu32;
#define RLX_AGENT __ATOMIC_RELAXED, __HIP_MEMORY_SCOPE_AGENT
#define XB_TMO      128
#define XB_XCNT(j)  (256  + 64 * (j))
#define XB_XSUB(j)  (1280 + 64 * (j))
#define XB_XGEN(j)  (2304 + 64 * (j))
#define XB_TOP      3328
#define XB_TOPGEN   3392
#define XCD_BAR_WORDS 3456
#define XB_SPIN_CAP (1u << 22)

__device__ __forceinline__ unsigned xb_ld(unsigned* p)              { return __hip_atomic_load(p, __ATOMIC_RELAXED, __HIP_MEMORY_SCOPE_AGENT); }
__device__ __forceinline__ unsigned xb_add(unsigned* p, unsigned v) { return __hip_atomic_fetch_add(p, v, __ATOMIC_RELAXED, __HIP_MEMORY_SCOPE_AGENT); }
__device__ __forceinline__ unsigned xb_xcc_id() { return (unsigned)__builtin_amdgcn_s_getreg((3 << 11) | 20) & 0xFu; }
#define XB_SPIN(cond, bar) do { unsigned _sp = 0; while (cond) { __builtin_amdgcn_s_sleep(1); \
    if ((++_sp & 255u) == 0u) { if (xb_ld(&(bar)[XB_TMO])) break; if (_sp > XB_SPIN_CAP) { atomicAdd(&(bar)[XB_TMO], 1u); break; } } } } while (0)

struct XcdBarrier { unsigned* bar; unsigned x; volatile LAS unsigned* st; };
__device__ __forceinline__ XcdBarrier xcd_barrier_post(unsigned* bar, volatile LAS unsigned* st, int wv) {
    XcdBarrier b; b.bar = bar; b.x = xb_xcc_id(); b.st = st;
    if (wv == 0 && lane_id() == 0) (void)xb_add(&bar[XB_XCNT(b.x)], 1u);
    return b;
}
__device__ __forceinline__ void xcd_barrier_complete(unsigned* bar, unsigned x, unsigned& nloc, unsigned& nx) {
    const unsigned G = gridDim.x * gridDim.y * gridDim.z;
    unsigned sum, cnt, mine, sp = 0u;
    for (;;) {
        sum = 0u; cnt = 0u; mine = 0u;
#pragma unroll
        for (unsigned j = 0; j < 16; ++j) { const unsigned c = xb_ld(&bar[XB_XCNT(j)]); sum += c; cnt += (c > 0u) ? 1u : 0u; mine = (j == x) ? c : mine; }
        if (sum == G) break;
        __builtin_amdgcn_s_sleep(1);
        if ((++sp & 255u) == 0u) { if (xb_ld(&bar[XB_TMO])) break; if (sp > XB_SPIN_CAP) { atomicAdd(&bar[XB_TMO], 1u); break; } }
    }
    nloc = mine > 0u ? mine : 1u; nx = cnt > 0u ? cnt : 1u;
}
__device__ __forceinline__ void xcd_barrier(const XcdBarrier& b, int wv) {
    asm volatile("s_waitcnt vmcnt(0)" ::: "memory");
    __syncthreads();
    if (wv == 0 && lane_id() == 0) {
        unsigned* bar = b.bar;
        __builtin_amdgcn_s_waitcnt(0);
        unsigned nloc = b.st[0], nx = b.st[1];
        if (nloc == 0u) { xcd_barrier_complete(bar, b.x, nloc, nx); b.st[0] = nloc; b.st[1] = nx; }
        const unsigned old = xb_add(&bar[XB_XSUB(b.x)], 1u);
        const unsigned gen = old / nloc;
        if (old + 1u == (gen + 1u) * nloc) {
            __builtin_amdgcn_fence(__ATOMIC_RELEASE, "agent");
            asm volatile("s_waitcnt vmcnt(0)" ::: "memory");
            const unsigned og = xb_add(&bar[XB_TOP], 1u);
            const unsigned tg = og / nx;
            if (og + 1u == (tg + 1u) * nx) xb_add(&bar[XB_TOPGEN], 1u);
            else XB_SPIN(xb_ld(&bar[XB_TOPGEN]) == tg, bar);
            __builtin_amdgcn_fence(__ATOMIC_ACQUIRE, "agent");
            xb_add(&bar[XB_XGEN(b.x)], 1u);
            asm volatile("s_waitcnt vmcnt(0)" ::: "memory");
        } else {
            XB_SPIN(xb_ld(&bar[XB_XGEN(b.x)]) == gen, bar);
            __builtin_amdgcn_fence(__ATOMIC_ACQUIRE, "agent");
            asm volatile("s_waitcnt vmcnt(0)" ::: "memory");
        }
    }
    __syncthreads();
}

struct Args { const float* in[33]; float* out; unsigned char* ws; int ph_lo, ph_hi; };
typedef const Args __attribute__((address_space(4))) * KArgs;
struct Frame {
    LAS unsigned char* lds; volatile LAS unsigned* MISC; unsigned* ctl;
    int tid, lane, wave, vcu, G;
    unsigned char* ws;
};

struct TrDesc { const float* src; bf16_t* dst; const float* gain; int K, N, Npad, nb; size_t sbs, dbs; int gdiv, gstride, map, drow0, f8, b0; float qs; unsigned* amax; };
__device__ __forceinline__ int tr_items(const TrDesc& d) { return (d.K / 64) * (d.Npad / 64) * d.nb; }
__device__ __forceinline__ void tr_load(const TrDesc& d, int item, int lane, f32x4 (&va)[8], f32x4 (&vb)[8]) {
    const int nblk = d.Npad / 64, per = nblk * (d.K / 64);
    const int b = d.b0 + item / per, r = item % per, kb = r / nblk, nbk = r % nblk, k0 = 64 * kb, n0 = 64 * nbk;
    const float* W = d.src + (size_t)b * d.sbs;
    const int l16 = lane & 15, kq = lane >> 4, n = n0 + 4 * l16; const bool valid = n < d.N;
#pragma unroll
    for (int i = 0; i < 8; ++i) { const int k = k0 + 2 * (4 * i + kq);
        va[i] = valid ? __builtin_nontemporal_load((const f32x4*)(W + (size_t)k * d.N + n)) : (f32x4){0.f, 0.f, 0.f, 0.f};
        vb[i] = valid ? __builtin_nontemporal_load((const f32x4*)(W + (size_t)(k + 1) * d.N + n)) : (f32x4){0.f, 0.f, 0.f, 0.f}; }
}
__device__ __forceinline__ void tr_finish(const TrDesc& d, int item, int lane, const f32x4 (&va)[8], const f32x4 (&vb)[8], LAS unsigned* scr) {
    const int nblk = d.Npad / 64, per = nblk * (d.K / 64);
    const int b = d.b0 + item / per, r = item % per, kb = r / nblk, nbk = r % nblk, k0 = 64 * kb, n0 = 64 * nbk;
    const float* gn = d.gain ? d.gain + (size_t)(b / d.gdiv) * d.gstride : nullptr;
    const int l16 = lane & 15, kq = lane >> 4; float amx = 0.f;
#pragma unroll
    for (int i = 0; i < 8; ++i) { const int kp = 4 * i + kq; float ga = 1.f, gb = 1.f; if (gn) { ga = gn[k0 + 2 * kp]; gb = gn[k0 + 2 * kp + 1]; }
        if (d.f8 == 1) {
#pragma unroll
            for (int e = 0; e < 4; ++e) ((LAS unsigned short*)scr)[(4 * l16 + e) * 34 + kp] = (unsigned short)__builtin_amdgcn_cvt_pk_fp8_f32(va[i][e] * (ga * 64.f), vb[i][e] * (gb * 64.f), 0, false);
        } else if (d.f8 == 3) {
#pragma unroll
            for (int e = 0; e < 4; ++e) { const int qa = (int)__builtin_rintf(va[i][e] * (ga * d.qs)), qb = (int)__builtin_rintf(vb[i][e] * (gb * d.qs)); ((LAS unsigned short*)scr)[(4 * l16 + e) * 34 + kp] = (unsigned short)((qa & 0xFF) | ((qb & 0xFF) << 8)); }
        } else if (d.f8 == 2) {
#pragma unroll
            for (int e = 0; e < 4; ++e) amx = fmaxf(amx, fmaxf(fabsf(va[i][e] * ga), fabsf(vb[i][e] * gb)));
        } else {
#pragma unroll
            for (int e = 0; e < 4; ++e) scr[(4 * l16 + e) * 33 + kp] = pk2(va[i][e] * ga, vb[i][e] * gb); } }
    if (d.f8 == 2) {
#pragma unroll
        for (int o = 1; o < 64; o <<= 1) amx = fmaxf(amx, __shfl_xor(amx, o));
        if (lane == 0 && __builtin_bit_cast(unsigned, amx) > __hip_atomic_load(d.amax + 64 * b, __ATOMIC_RELAXED, __HIP_MEMORY_SCOPE_AGENT))
            __hip_atomic_fetch_max(d.amax + 64 * b, __builtin_bit_cast(unsigned, amx), __ATOMIC_RELAXED, __HIP_MEMORY_SCOPE_AGENT);
        return; }
    LDS_WAIT(); asm volatile("" ::: "memory");
    int dr;
    if (d.map == 1) { const int half = d.N / 2, hh = n0 / half, nn = n0 % half; dr = (nn / 128) * 256 + hh * 128 + (nn % 128); } else dr = d.drow0 + n0;
    if (d.f8 == 1 || d.f8 == 3) {
        unsigned char* W8 = (unsigned char*)d.dst + (size_t)b * d.dbs; const int c4 = lane & 3;
#pragma unroll
        for (int j = 0; j < 4; ++j) { const int nl = (lane >> 2) + 16 * j; const LAS unsigned* sp = scr + nl * 17 + 4 * c4;
            u32x4 o; o.x = sp[0]; o.y = sp[1]; o.z = sp[2]; o.w = sp[3];
            *(u32x4*)(W8 + (size_t)(dr + nl) * d.K + k0 + 16 * c4) = o; }
        LDS_WAIT(); asm volatile("" ::: "memory");
        return;
    }
    bf16_t* WT = d.dst + (size_t)b * d.dbs;
    const int c = lane & 7;
#pragma unroll
    for (int j = 0; j < 8; ++j) { const int nl = (lane >> 3) + 8 * j; const LAS unsigned* sp = scr + nl * 33 + 4 * c;
        u32x4 o; o.x = sp[0]; o.y = sp[1]; o.z = sp[2]; o.w = sp[3];
        *(u32x4*)(WT + (size_t)(dr + nl) * d.K + k0 + 8 * c) = o; }
    LDS_WAIT(); asm volatile("" ::: "memory");
}
constexpr int N_TR = 13;
__device__ __forceinline__ TrDesc tr_desc(int kind, int stage, KArgs a, unsigned char* ws) { TrDesc d; d.gain = nullptr; d.b0 = 0; d.qs = 1.f; d.amax = (unsigned*)ws + CW_WMAX; d.gdiv = 1; d.gstride = 0; d.map = 0; d.drow0 = 0;
    switch (kind) {
    case 0:  d.src = a->in[6];  d.dst = (bf16_t*)(ws + WS_WIN);  d.K = 1024; d.N = 2048; d.nb = 2;  d.gain = a->in[2]; d.gstride = 1024; break;
    case 1:  d.src = a->in[14]; d.dst = (bf16_t*)(ws + WS_WOUT); d.K = 1024; d.N = 1024; d.nb = 2;  break;
    case 2:  d.src = a->in[26]; d.dst = (bf16_t*)(ws + WS_WGU);  d.K = 1024; d.N = 6144; d.nb = 2;  d.gain = a->in[3]; d.gstride = 2048; d.map = 1; break;
    case 3:  d.src = a->in[27]; d.dst = (bf16_t*)(ws + WS_WDN);  d.K = 3072; d.N = 1024; d.nb = 2;  break;
    case 4:  d.src = a->in[29]; d.dst = (bf16_t*)(ws + WS_WMGU); d.K = 1024; d.N = 7168; d.nb = 16; d.gain = a->in[3] + 1024; d.gdiv = 8; d.gstride = 2048; d.map = 1; break;
    case 5:  d.src = a->in[30]; d.dst = (bf16_t*)(ws + WS_WMDN); d.K = 3584; d.N = 1024; d.nb = 16; break;
    case 6:  d.src = a->in[32]; d.dst = (bf16_t*)(ws + WS_WPG);  d.K = 1024; d.N = 1024; d.nb = 4;  d.gain = a->in[4]; d.gstride = 1024; break;
    case 7:  d.src = a->in[31]; d.dst = (bf16_t*)(ws + WS_WPP);  d.K = 256;  d.N = 1024; d.nb = 4;  break;
    case 8:  d.src = a->in[16]; d.dst = (bf16_t*)(ws + WS_WKVQ); d.K = 1024; d.N = 768;  d.nb = 1;  d.gain = a->in[15]; break;
    case 9:  d.src = a->in[24]; d.dst = (bf16_t*)(ws + WS_WKVQ); d.K = 1024; d.N = 1072; d.nb = 2;  d.gain = a->in[2] + 2048; d.gstride = 1024; d.drow0 = 768; break;
    case 10: d.src = a->in[25]; d.dst = (bf16_t*)(ws + WS_WO);   d.K = 1024; d.N = 1024; d.nb = 2;  break;
    case 11: d.src = a->in[19]; d.dst = (bf16_t*)(ws + WS_WC1);  d.K = 2048; d.N = 256;  d.nb = 1;  break;
    default: d.src = a->in[21]; d.dst = (bf16_t*)(ws + WS_WC1) + 256 * 2048; d.K = 2048; d.N = 256; d.nb = 1; break;
    }
    d.Npad = (kind == 9) ? 1280 : d.N; d.f8 = (kind == 4 || kind == 5) ? 1 : 0;
    d.sbs = (size_t)d.K * d.N; d.dbs = (size_t)d.K * ((kind == 9 || kind == 8) ? 2048 : d.N);
    if (kind == 2) d.f8 = (stage >= 3) ? 3 : 2;
    if (stage >= 3) { if (kind == 2) { d.b0 = stage - 3; d.nb = 1; const float wm = __builtin_bit_cast(float, __hip_atomic_load(d.amax + 64 * d.b0, __ATOMIC_RELAXED, __HIP_MEMORY_SCOPE_AGENT)); d.qs = wm > 0.f ? 127.0f / wm : 0.f; } else d.nb = 0; return d; }
    if (stage == 0) { if (kind == 2 || kind == 3) d.nb = 1; else if (kind == 4 || kind == 5) d.nb = 8; else if (kind == 6) d.nb = 2; else if (kind == 10) d.nb = 0; }
    else if (stage == 1) { if (kind == 2 || kind == 3) { d.b0 = 1; d.nb = 1; } else if (kind == 6) { d.b0 = 2; d.nb = 2; } else if (kind == 10) { d.b0 = 0; d.nb = 2; } else if (kind == 4 || kind == 5) { d.b0 = 8; d.nb = 4; } else d.nb = 0; }
    else { if (kind == 4 || kind == 5) { d.b0 = 12; d.nb = 4; } else d.nb = 0; }
    return d;
}
__device__ __forceinline__ void tr_run(KArgs a, unsigned char* ws, int stage, int gwe, int nge, LAS unsigned* scr, int lane) {
    int base = 0;
    for (int kind = 0; kind < N_TR; ++kind) {
        const TrDesc d = tr_desc(kind, stage, a, ws); const int n = tr_items(d);
        if (n == 0) continue;
        int first = gwe - (base % nge); if (first < 0) first += nge;
        if (first < n) {
            f32x4 a0[8], b0[8], a1[8], b1[8]; int it = first;
            tr_load(d, it, lane, a0, b0);
            for (;;) {
                const int it1 = it + nge; const bool h1 = it1 < n; if (h1) tr_load(d, it1, lane, a1, b1);
                __builtin_amdgcn_sched_barrier(0);
                tr_finish(d, it, lane, a0, b0, scr);
                if (!h1) break;
                const int it2 = it1 + nge; const bool h2 = it2 < n; if (h2) tr_load(d, it2, lane, a0, b0);
                __builtin_amdgcn_sched_barrier(0);
                tr_finish(d, it1, lane, a1, b1, scr);
                if (!h2) break;
                it = it2;
            }
        }
        base += n;
    }
}
__device__ __forceinline__ void p0_prologue(Frame& F, KArgs a) {
    LAS unsigned* scr = (LAS unsigned*)(F.lds + RING_OFF + F.wave * 16384);
    const int gw = F.vcu * NWAVES + F.wave, NGW = F.G * NWAVES;
    tr_run(a, F.ws, 0, gw, NGW, scr, F.lane);
    { const float* x = a->in[0]; bf16_t* xb = (bf16_t*)(F.ws + WS_XB0); float* ss = (float*)(F.ws + WS_SS0);
      for (int m0 = gw * 4; m0 < M; m0 += NGW * 4) {
          f32x4 v[4][4];
#pragma unroll
          for (int q = 0; q < 4; ++q)
#pragma unroll
              for (int j = 0; j < 4; ++j) v[q][j] = ((const f32x4*)(x + (size_t)(m0 + q) * DM) + F.lane)[64 * j];
#pragma unroll
          for (int q = 0; q < 4; ++q) { float s = 0.f; u32x2* o8 = (u32x2*)(xb + (size_t)(m0 + q) * DM) + F.lane;
#pragma unroll
              for (int j = 0; j < 4; ++j) { const f32x4 vv = v[q][j]; s += (vv[0] * vv[0] + vv[1] * vv[1]) + (vv[2] * vv[2] + vv[3] * vv[3]); u32x2 w; w.x = pk2(vv[0], vv[1]); w.y = pk2(vv[2], vv[3]); o8[64 * j] = w; }
              s = wave_sum(s);
              if (F.lane < 16) ss[(size_t)(m0 + q) * 16 + F.lane] = (F.lane == 0) ? s : 0.f; } } }
    { const float* p = a->in[1]; bf16_t* pb = (bf16_t*)(F.ws + WS_PB); const size_t n8 = (size_t)4 * M * DPLE / 8;
      for (size_t i = (size_t)opaque_s((int)blockIdx.x) * 512 + F.tid; i < n8; i += (size_t)F.G * 512) {
          const f32x4 v0 = *(const f32x4*)(p + i * 8), v1 = *(const f32x4*)(p + i * 8 + 4);
          u32x4 w; w.x = pk2(v0[0], v0[1]); w.y = pk2(v0[2], v0[3]); w.z = pk2(v1[0], v1[1]); w.w = pk2(v1[2], v1[3]);
          *(u32x4*)(pb + i * 8) = w; } }
    { float* cb = (float*)(F.ws + WS_SMALL);
      for (int o = gw; o < 512; o += NGW) { const int kv = o >> 8, j = o & 255; const float* pos = a->in[17 + kv]; const float* w1 = a->in[kv ? 21 : 19];
          float s = 0.f; for (int k = F.lane; k < 2048; k += 64) s += pos[k] * w1[(size_t)k * 256 + j];
          s = wave_sum(s); if (F.lane == 0) cb[o] = s; } }
}

__device__ __forceinline__ void rg_phase(Frame& F, KArgs a, int la) {
    const bf16_t* GX = (const bf16_t*)(F.ws + WS_GXK); bf16_t* Y = (bf16_t*)(F.ws + WS_YO);
    const float* conv_w = a->in[7] + (size_t)la * 4 * 1024; const float* conv_b = a->in[8] + (size_t)la * 1024;
    const float* w_a = a->in[9] + (size_t)la * 16 * 64 * 64; const float* b_a = a->in[10] + (size_t)la * 1024;
    const float* w_x = a->in[11] + (size_t)la * 16 * 64 * 64; const float* b_x = a->in[12] + (size_t)la * 1024;
    const float* lam = a->in[13] + (size_t)la * 1024;
    LAS bf16_t* xcb = (LAS bf16_t*)(F.lds + RING_OFF);
    LAS float* cw = (LAS float*)(F.lds + RING_OFF + 40960);
    LAS float* wtot = (LAS float*)(F.lds + RING_OFF + 43008);
    const int lane = F.lane, w = F.wave, fr = lane & 15, fq = lane >> 4;
    for (int unit = opaque_s((int)blockIdx.x); unit < 256; unit += F.G) {
        const int b = unit >> 5, n = (unit >> 1) & 15, oc = unit & 1;
        __syncthreads();
        if (F.tid < 256) cw[F.tid] = conv_w[(size_t)(F.tid >> 6) * 1024 + n * 64 + (F.tid & 63)];
        else if (F.tid < 320) cw[F.tid] = conv_b[n * 64 + (F.tid - 256)];
        float ba[2], bx[2], sp[2]; bf16x8 wa[2][2], wx[2][2];
#pragma unroll
        for (int nt = 0; nt < 2; ++nt) { const int ch = n * 64 + oc * 32 + nt * 16 + fr; ba[nt] = b_a[ch]; bx[nt] = b_x[ch];
            const float l = lam[ch]; sp[nt] = (l > 15.f) ? __expf(-l) : log1pf(__expf(-l));
#pragma unroll
            for (int ks = 0; ks < 2; ++ks) {
                const float* pa = w_a + ((size_t)n * 64 + ks * 32 + fq * 8) * 64 + oc * 32 + nt * 16 + fr; const float* px = w_x + ((size_t)n * 64 + ks * 32 + fq * 8) * 64 + oc * 32 + nt * 16 + fr;
                u32x4 ua, ux; ua.x = pk2(pa[0], pa[64]); ua.y = pk2(pa[128], pa[192]); ua.z = pk2(pa[256], pa[320]); ua.w = pk2(pa[384], pa[448]);
                ux.x = pk2(px[0], px[64]); ux.y = pk2(px[128], px[192]); ux.z = pk2(px[256], px[320]); ux.w = pk2(px[384], px[448]);
                wa[ks][nt] = __builtin_bit_cast(bf16x8, ua); wx[ks][nt] = __builtin_bit_cast(bf16x8, ux); } }
        float carry[2] = {0.f, 0.f};
        __syncthreads();
        u32x4 cv[2][4];
#define RG_LOAD_CONV(chunk_) do { _Pragma("unroll") for (int ii = 0; ii < 2; ++ii) { const int it = F.tid + ii * 512, tok = it >> 3, g8 = it & 7, t = (chunk_) * 128 + tok; \
            _Pragma("unroll") for (int k = 0; k < 4; ++k) { const int tt = t - 3 + k; cv[ii][k] = (tt >= 0) ? *(const u32x4*)(GX + ((size_t)(b * SEQ + tt)) * 2048 + 1024 + n * 64 + g8 * 8) : (u32x4){0u, 0u, 0u, 0u}; } } } while (0)
        RG_LOAD_CONV(0);
        for (int chunk = 0; chunk < 16; ++chunk) {
            const int buf = chunk & 1; LAS bf16_t* xc = xcb + buf * (128 * 72);
#pragma unroll
            for (int ii = 0; ii < 2; ++ii) { const int it = F.tid + ii * 512, tok = it >> 3, g8 = it & 7;
                float ac[8];
#pragma unroll
                for (int e = 0; e < 8; ++e) ac[e] = cw[256 + g8 * 8 + e];
#pragma unroll
                for (int k = 0; k < 4; ++k) { const u32x4 v = cv[ii][k];
                    const LAS float* ck = cw + k * 64 + g8 * 8;
                    ac[0] += ck[0] * bflo(v.x); ac[1] += ck[1] * bfhi(v.x); ac[2] += ck[2] * bflo(v.y); ac[3] += ck[3] * bfhi(v.y);
                    ac[4] += ck[4] * bflo(v.z); ac[5] += ck[5] * bfhi(v.z); ac[6] += ck[6] * bflo(v.w); ac[7] += ck[7] * bfhi(v.w); }
                u32x4 o; o.x = pk2(ac[0], ac[1]); o.y = pk2(ac[2], ac[3]); o.z = pk2(ac[4], ac[5]); o.w = pk2(ac[6], ac[7]);
                *(LAS u32x4*)(xc + tok * 72 + g8 * 8) = o; }
            if (chunk + 1 < 16) RG_LOAD_CONV(chunk + 1);
            bf16_t gq[2][4];
#pragma unroll
            for (int nt = 0; nt < 2; ++nt)
#pragma unroll
                for (int e = 0; e < 4; ++e) gq[nt][e] = GX[((size_t)b * SEQ + chunk * 128 + 16 * w + 4 * fq + e) * 2048 + n * 64 + oc * 32 + nt * 16 + fr];
            __syncthreads();
            f32x4 ra[2], xi[2];
            { const bf16x8 A0 = *(const LAS bf16x8*)(xc + (16 * w + fr) * 72 + fq * 8), A1 = *(const LAS bf16x8*)(xc + (16 * w + fr) * 72 + 32 + fq * 8);
#pragma unroll
              for (int nt = 0; nt < 2; ++nt) {
                  ra[nt] = __builtin_amdgcn_mfma_f32_16x16x32_bf16(A0, wa[0][nt], (f32x4){0.f, 0.f, 0.f, 0.f}, 0, 0, 0); ra[nt] = __builtin_amdgcn_mfma_f32_16x16x32_bf16(A1, wa[1][nt], ra[nt], 0, 0, 0);
                  xi[nt] = __builtin_amdgcn_mfma_f32_16x16x32_bf16(A0, wx[0][nt], (f32x4){0.f, 0.f, 0.f, 0.f}, 0, 0, 0); xi[nt] = __builtin_amdgcn_mfma_f32_16x16x32_bf16(A1, wx[1][nt], xi[nt], 0, 0, 0); } }
            float hl[2][4], pl[2][4], Pw[2], Hw[2];
#pragma unroll
            for (int nt = 0; nt < 2; ++nt) { float H = 0.f, P = 1.f;
#pragma unroll
                for (int e = 0; e < 4; ++e) { const int tok = 16 * w + 4 * fq + e;
                    const float xv = bf1(xc[tok * 72 + oc * 32 + nt * 16 + fr]);
                    const float r = sigmoidf_(ra[nt][e] + ba[nt]), ig = sigmoidf_(xi[nt][e] + bx[nt]);
                    const float la_ = -8.0f * r * sp[nt], av = ex2(la_ * LOG2E), t2 = 2.0f * la_;
                    const float om = -t2 * (1.0f + t2 * (0.5f + t2 * (0.16666667f + t2 * (0.041666668f + t2 * 0.0083333338f))));
                    const float uu = __builtin_sqrtf(fmaxf(om, 0.f)) * ig * xv;
                    H = av * H + uu; P = P * av; hl[nt][e] = H; pl[nt][e] = P; }
                float Pi = P, Hi = H;
                { const float Pp = __shfl_up(Pi, 16), Hp = __shfl_up(Hi, 16); if (fq >= 1) { Hi = Pi * Hp + Hi; Pi = Pi * Pp; } }
                { const float Pp = __shfl_up(Pi, 32), Hp = __shfl_up(Hi, 32); if (fq >= 2) { Hi = Pi * Hp + Hi; Pi = Pi * Pp; } }
                float Pe = __shfl_up(Pi, 16), He = __shfl_up(Hi, 16); if (fq == 0) { Pe = 1.f; He = 0.f; }
                if (fq == 3) { wtot[((buf * 8 + w) * 32 + nt * 16 + fr) * 2] = Pi; wtot[((buf * 8 + w) * 32 + nt * 16 + fr) * 2 + 1] = Hi; }
                Pw[nt] = Pe; Hw[nt] = He; }
            __syncthreads();
#pragma unroll
            for (int nt = 0; nt < 2; ++nt) { float c = carry[nt], cin = 0.f;
#pragma unroll
                for (int ww = 0; ww < 8; ++ww) { const float A_ = wtot[((buf * 8 + ww) * 32 + nt * 16 + fr) * 2], H_ = wtot[((buf * 8 + ww) * 32 + nt * 16 + fr) * 2 + 1];
                    if (ww == w) cin = c; c = A_ * c + H_; }
                carry[nt] = c;
                const float cl = Pw[nt] * cin + Hw[nt];
#pragma unroll
                for (int e = 0; e < 4; ++e) { const size_t row = (size_t)b * SEQ + chunk * 128 + 16 * w + 4 * fq + e; const int ch = n * 64 + oc * 32 + nt * 16 + fr;
                    const float hv = hl[nt][e] + pl[nt][e] * cl; const float gg = bf1(gq[nt][e]);
                    Y[row * DM + ch] = (bf16_t)f2bf(gg * hv); } }
        }
    }
}

#undef RG_LOAD_CONV
__device__ __forceinline__ int crow(int r, int hi) { return (r & 3) + 8 * (r >> 2) + 4 * hi; }
__device__ __forceinline__ int rel_bucket_i(int n) {
    if (n < 16) return n;
    return 16 + (n >= 19) + (n >= 21) + (n >= 24) + (n >= 27) + (n >= 31) + (n >= 35) + (n >= 40) + (n >= 46) + (n >= 52) + (n >= 59) + (n >= 67) + (n >= 77) + (n >= 87) + (n >= 99) + (n >= 113);
}
__device__ __forceinline__ float sum8_dpp(float v) {
    v += __builtin_bit_cast(float, __builtin_amdgcn_update_dpp(0, __builtin_bit_cast(int, v), 0xB1, 0xF, 0xF, false));
    v += __builtin_bit_cast(float, __builtin_amdgcn_update_dpp(0, __builtin_bit_cast(int, v), 0x4E, 0xF, 0xF, false));
    v += __builtin_bit_cast(float, __builtin_amdgcn_update_dpp(0, __builtin_bit_cast(int, v), 0x141, 0xF, 0xF, false));
    return v;
}
struct KVF { bf16x8 k[4]; bf16x8 v[2][2]; };
__device__ __forceinline__ void load_k(KVF& t, const char* tile, unsigned loff) {
#pragma unroll
    for (int d0 = 0; d0 < 4; ++d0) t.k[d0] = *(const bf16x8*)(tile + loff + d0 * 1024);
}
__device__ __forceinline__ void load_v(KVF& t, const char* tile, unsigned loff) {
#pragma unroll
    for (int dt = 0; dt < 2; ++dt)
#pragma unroll
        for (int s = 0; s < 2; ++s) t.v[dt][s] = *(const bf16x8*)(tile + loff + (dt * 2 + s) * 1024);
}
__device__ __forceinline__ f32x16 attn_qk(const KVF& t, const bf16x8 (&qr)[4], float init) {
    f32x16 s;
#pragma unroll
    for (int r = 0; r < 16; ++r) s[r] = init;
#pragma unroll
    for (int d0 = 0; d0 < 4; ++d0) s = __builtin_amdgcn_mfma_f32_32x32x16_bf16(t.k[d0], qr[d0], s, 0, 0, 0);
    return s;
}
__device__ __forceinline__ void attn_pv(const f32x16& P, f32x16 (&o)[2], const KVF& t) {
#pragma unroll
    for (int s = 0; s < 2; ++s) {
        u32x4 pw; pw.x = pk2(P[8 * s + 0], P[8 * s + 1]); pw.y = pk2(P[8 * s + 2], P[8 * s + 3]); pw.z = pk2(P[8 * s + 4], P[8 * s + 5]); pw.w = pk2(P[8 * s + 6], P[8 * s + 7]);
        const bf16x8 pb = __builtin_bit_cast(bf16x8, pw);
#pragma unroll
        for (int dt = 0; dt < 2; ++dt) o[dt] = __builtin_amdgcn_mfma_f32_32x32x16_bf16(t.v[dt][s], pb, o[dt], 0, 0, 0); }
}
__device__ __forceinline__ float max3f(float a, float b, float c) { float r; asm("v_max3_f32 %0, %1, %2, %3" : "=v"(r) : "v"(a), "v"(b), "v"(c)); return r; }
typedef float f32x8 __attribute__((ext_vector_type(8)));
__device__ __forceinline__ void attn_step(f32x16& S, float cb, float& m, float& l, f32x16 (&o)[2], const KVF& t) {
    float mx = max3f(S[0], S[1], S[2]);
#pragma unroll
    for (int r = 3; r < 15; r += 2) mx = max3f(mx, S[r], S[r + 1]);
    mx = fmaxf(mx, S[15]);
    mx = fmaxf(mx, __shfl_xor(mx, 32)) + cb;
    const float mn = fmaxf(m, mx), dlt = cb - mn;
    float rs = 0.f;
#pragma unroll
    for (int r = 0; r < 16; ++r) { S[r] = ex2(S[r] + dlt); rs += S[r]; }
    rs += __shfl_xor(rs, 32);
    if (__any(mn > m)) { const float alpha = ex2(m - mn); l *= alpha;
#pragma unroll
        for (int dt = 0; dt < 2; ++dt)
#pragma unroll
            for (int r = 0; r < 16; ++r) o[dt][r] *= alpha; }
    l += rs; m = mn;
    attn_pv(S, o, t);
}
template <int WIN>
__device__ __forceinline__ float attn_scores(f32x16& S, const bf16x8 (&k)[4], int tt, const bf16x8 (&qr)[4], unsigned sel, int s0, int stok, int hi, const LAS float* lut_h, float c31) {
    const int key0 = 32 * tt; const bool selc = WIN ? true : (((sel >> (tt >> 1)) & 1u) != 0u);
    const bool far = WIN ? (s0 - (key0 + 31) >= 127 && s0 + 3 - key0 <= 511) : (s0 - (key0 + 31) >= 127);
#pragma unroll
    for (int r = 0; r < 16; ++r) S[r] = 0.f;
#pragma unroll
    for (int d0 = 0; d0 < 4; ++d0) S = __builtin_amdgcn_mfma_f32_32x32x16_bf16(k[d0], qr[d0], S, 0, 0, 0);
    if (far) return selc ? c31 : -1e30f;
    const LAS float* p = lut_h + (stok - key0 - 4 * hi - 27);
#pragma unroll
    for (int r = 0; r < 16; ++r) S[r] += p[27 - ((r & 3) + 8 * (r >> 2))];
    return selc ? 0.f : -1e30f;
}
__device__ __forceinline__ float rowmax16(const f32x16& S) {
    float mx = max3f(S[0], S[1], S[2]);
#pragma unroll
    for (int r = 3; r < 15; r += 2) mx = max3f(mx, S[r], S[r + 1]);
    return fmaxf(mx, S[15]);
}
__device__ __forceinline__ void attn_pv2(const f32x16& P, f32x16 (&o)[2], const bf16x8 (&v)[2][2]) {
#pragma unroll
    for (int s = 0; s < 2; ++s) {
        u32x4 pw; pw.x = pk2(P[8 * s + 0], P[8 * s + 1]); pw.y = pk2(P[8 * s + 2], P[8 * s + 3]); pw.z = pk2(P[8 * s + 4], P[8 * s + 5]); pw.w = pk2(P[8 * s + 6], P[8 * s + 7]);
        const bf16x8 pb = __builtin_bit_cast(bf16x8, pw);
#pragma unroll
        for (int dt = 0; dt < 2; ++dt) o[dt] = __builtin_amdgcn_mfma_f32_32x32x16_bf16(v[dt][s], pb, o[dt], 0, 0, 0); }
}
__device__ __forceinline__ float exp2_fast(float s, float c23) {
    float r; asm("v_cvt_u32_f32 %0, %1" : "=v"(r) : "v"(__builtin_fmaf(s, 8388608.0f, c23))); return r;
}
__device__ __forceinline__ float cvt_sat_u32(float x) { float r; asm("v_cvt_u32_f32 %0, %1" : "=v"(r) : "v"(x)); return r; }
template <int WIN>
__device__ __forceinline__ void attn_pair(const bf16x8 (&k0)[4], const bf16x8 (&k1)[4], const bf16x8 (&v0)[2][2], const bf16x8 (&v1)[2][2], int t0, int t1, const bf16x8 (&qr)[4],
                                          float& m, float& l, f32x16 (&o)[2], unsigned sel, int s0, int stok, int hi, const LAS float* lut_h, float c31) {
    f32x16 S0, S1; float cb1 = -1e30f;
    const float cb0 = attn_scores<WIN>(S0, k0, t0, qr, sel, s0, stok, hi, lut_h, c31);
    if (t1 >= 0) cb1 = attn_scores<WIN>(S1, k1, t1, qr, sel, s0, stok, hi, lut_h, c31);
    else {
#pragma unroll
        for (int r = 0; r < 16; ++r) S1[r] = 0.f; }
    float mx = fmaxf(rowmax16(S0) + cb0, rowmax16(S1) + cb1);
    mx = fmaxf(mx, __shfl_xor(mx, 32));
    const float mn = fmaxf(m, mx), c0 = fmaxf((cb0 - mn + 127.0f) * 8388608.0f, -3.0e38f), c1 = fmaxf((cb1 - mn + 127.0f) * 8388608.0f, -3.0e38f);
    const f32x2 k23 = {8388608.0f, 8388608.0f}, c0v = {c0, c0}, c1v = {c1, c1};
    f32x2 rs2 = {0.f, 0.f};
#pragma unroll
    for (int r = 0; r < 16; r += 2) {
        const f32x2 x0 = __builtin_elementwise_fma((f32x2){S0[r], S0[r + 1]}, k23, c0v), x1 = __builtin_elementwise_fma((f32x2){S1[r], S1[r + 1]}, k23, c1v);
        f32x2 e0, e1; e0.x = cvt_sat_u32(x0.x); e0.y = cvt_sat_u32(x0.y); e1.x = cvt_sat_u32(x1.x); e1.y = cvt_sat_u32(x1.y);
        S0[r] = e0.x; S0[r + 1] = e0.y; S1[r] = e1.x; S1[r + 1] = e1.y;
        rs2 += e0 + e1; }
    float rs = rs2.x + rs2.y;
    rs += __shfl_xor(rs, 32);
    if (__any(mn > m)) { const float alpha = ex2(m - mn); l *= alpha;
#pragma unroll
        for (int dt = 0; dt < 2; ++dt)
#pragma unroll
            for (int r = 0; r < 16; ++r) o[dt][r] *= alpha; }
    l += rs; m = mn;
    attn_pv2(S0, o, v0);
    if (t1 >= 0) attn_pv2(S1, o, v1);
}
template <int WIN>
__device__ __forceinline__ void attn_branch(unsigned long long TM, const char* Kb, const char* Vb, unsigned loff, const bf16x8 (&qr)[4], LAS float* ost, float gate,
                                            unsigned sel, int s0, int stok, int hi, const LAS float* lut_h, float c31) {
    float m = -1e30f, l = 0.f; f32x16 o[2];
#pragma unroll
    for (int r = 0; r < 16; ++r) { o[0][r] = 0.f; o[1][r] = 0.f; }
#define POP_TILE(T) (WIN ? (63 - __builtin_clzll(T)) : __builtin_ctzll(T))
#define POP2(ta, tb) do { ta = -1; tb = -1; if (TM != 0ull) { ta = POP_TILE(TM); TM &= ~(1ull << ta); if (TM != 0ull) { tb = POP_TILE(TM); TM &= ~(1ull << tb); } } } while (0)
#define LOAD_K2(X, ta, tb) do { if ((ta) >= 0) { _Pragma("unroll") for (int d0 = 0; d0 < 4; ++d0) X[0][d0] = *(const bf16x8*)(Kb + (size_t)(ta) * 4096 + loff + d0 * 1024); } \
                                if ((tb) >= 0) { _Pragma("unroll") for (int d0 = 0; d0 < 4; ++d0) X[1][d0] = *(const bf16x8*)(Kb + (size_t)(tb) * 4096 + loff + d0 * 1024); } } while (0)
#define LOAD_V2(ta, tb) do { _Pragma("unroll") for (int q = 0; q < 4; ++q) va[0][q >> 1][q & 1] = *(const bf16x8*)(Vb + (size_t)(ta) * 4096 + loff + q * 1024); \
                             if ((tb) >= 0) { _Pragma("unroll") for (int q = 0; q < 4; ++q) va[1][q >> 1][q & 1] = *(const bf16x8*)(Vb + (size_t)(tb) * 4096 + loff + q * 1024); } } while (0)
    bf16x8 ka[2][4], kb[2][4], va[2][2][2];
    int a0, a1, b0, b1;
    POP2(a0, a1); LOAD_K2(ka, a0, a1);
    for (;;) {
        LOAD_V2(a0, a1);
        POP2(b0, b1); LOAD_K2(kb, b0, b1);
        __builtin_amdgcn_sched_barrier(0);
        attn_pair<WIN>(ka[0], ka[1], va[0], va[1], a0, a1, qr, m, l, o, sel, s0, stok, hi, lut_h, c31);
        if (b0 < 0) break;
        LOAD_V2(b0, b1);
        POP2(a0, a1); LOAD_K2(ka, a0, a1);
        __builtin_amdgcn_sched_barrier(0);
        attn_pair<WIN>(kb[0], kb[1], va[0], va[1], b0, b1, qr, m, l, o, sel, s0, stok, hi, lut_h, c31);
        if (a0 < 0) break;
    }
#undef POP_TILE
#undef POP2
#undef LOAD_K2
#undef LOAD_V2
    const float sc_ = gate / l;
#pragma unroll
    for (int dt = 0; dt < 2; ++dt)
#pragma unroll
        for (int r = 0; r < 16; ++r) ost[(dt * 16 + r) * 64] += sc_ * o[dt][r];
}
__device__ __forceinline__ void attn_phase(Frame& F, KArgs a, int slab) {
    const bf16_t* KVQ = (const bf16_t*)(F.ws + WS_GXK); const bf16_t* KC = (const bf16_t*)(F.ws + WS_KC); const bf16_t* VTC = KC + 16 * 128 * 64;
    const bf16_t* VTS = (const bf16_t*)(F.ws + WS_VTS); const bf16_t* VTW = (const bf16_t*)(F.ws + WS_VTW); bf16_t* O = (bf16_t*)(F.ws + WS_YO);
    const bf16_t* KFS = (const bf16_t*)(F.ws + WS_KFS); const bf16_t* KFW = (const bf16_t*)(F.ws + WS_KFW);
    LAS float* lut = (LAS float*)(F.lds + RING_OFF);
    __syncthreads();
    constexpr int LSTR = 612, LOFF = 40;
    for (int i = F.tid; i < 16 * LSTR; i += 512) { const int h = i / LSTR, d = i % LSTR - LOFF; lut[i] = (d >= 0 && d < 512) ? a->in[23][rel_bucket_i(d > 127 ? 127 : d) * 16 + h] * LOG2E : -1e30f; }
    __syncthreads();
    const int lane0 = F.lane, w = F.wave;
    LAS unsigned* scr = (LAS unsigned*)(F.lds + RING_OFF + 40960 + F.wave * 10240);
    if (w < 4) tr_run(a, F.ws, slab ? 2 : 1, F.vcu * NWAVES + w, F.G * NWAVES, scr, lane0);
    for (int ug = F.vcu; ug < 1024; ug += F.G) {
        const int lane = lane_id_fresh(), col = lane & 31, hi = lane >> 5, tl = col >> 3, r8 = col & 7; const unsigned loff = (unsigned)lane * 16u;
        int bg, q32;
        if (F.G == 256) {
            const int xq = F.vcu >> 5, wl = F.vcu & 31, a = wl >> 1, k = ug >> 8; bg = 2 * xq + (wl & 1);
            q32 = (k == 0) ? ((w < 4) ? a : 15 - a) : (k == 1) ? 16 + a : (k == 2) ? 47 - a : 63 - a; }
        else { bg = ug & 15; q32 = ug >> 4; }
        const int b = bg >> 1, g = bg & 1;
        const int s0 = q32 * 32 + w * 4, stok = s0 + tl, h = g * 8 + r8, qblk = s0 >> 6;
        const size_t row = (size_t)b * SEQ + stok;
        const LAS float* lut_h = lut + h * LSTR + LOFF; const float c31 = lut_h[127];
        bf16x8 qr[4];
#pragma unroll
        for (int d0 = 0; d0 < 4; ++d0) qr[d0] = *(const bf16x8*)(KVQ + row * NKVQ + QCOL + h * 64 + d0 * 16 + hi * 8);
        float gl0, gl1, gl2;
        if (slab) { const float* gs = (const float*)(F.ws + WS_GS) + row * 64 + h; gl0 = 0.f; gl1 = 0.f; gl2 = 0.f;
#pragma unroll
            for (int ks = 0; ks < 4; ++ks) { gl0 += gs[(size_t)ks * M * 64]; gl1 += gs[(size_t)ks * M * 64 + 16]; gl2 += gs[(size_t)ks * M * 64 + 32]; } }
        else { gl0 = bf1(KVQ[row * NKVQ + GCOL + h]); gl1 = bf1(KVQ[row * NKVQ + GCOL + 16 + h]); gl2 = bf1(KVQ[row * NKVQ + GCOL + 32 + h]); }
        const float g_cmp = sigmoidf_(gl0), g_slc = sigmoidf_(gl1), g_win = sigmoidf_(gl2);
        LAS float* ost = (LAS float*)scr + lane;
        unsigned sel;
        {
            KVF ct[4];
#pragma unroll
            for (int kt = 0; kt < 4; ++kt) load_k(ct[kt], (const char*)KC + ((size_t)bg * 4 + kt) * 4096, loff);
            f32x16 sc[4];
#pragma unroll
            for (int kt = 0; kt < 4; ++kt) sc[kt] = attn_qk(ct[kt], qr, 0.f);
            float mx = -1e30f;
#pragma unroll
            for (int kt = 0; kt < 4; ++kt) {
                float bias[16];
#pragma unroll
                for (int r = 0; r < 16; ++r) { const int c = 32 * kt + crow(r, hi), dist = stok - (16 * c + 31); const int idx = dist < 0 ? 0 : (dist > 127 ? 127 : dist); bias[r] = lut_h[idx]; }
#pragma unroll
                for (int r = 0; r < 16; ++r) { const int c = 32 * kt + crow(r, hi), dist = stok - (16 * c + 31);
                    const float sb = sc[kt][r] + bias[r]; const float v = (dist >= 0) ? sb : -1e30f; sc[kt][r] = v; mx = fmaxf(mx, v); }
                asm volatile("" ::: "memory");
            }
            mx = fmaxf(mx, __shfl_xor(mx, 32));
            float ls = 0.f;
#pragma unroll
            for (int kt = 0; kt < 4; ++kt)
#pragma unroll
                for (int r = 0; r < 16; ++r) { const float p = (sc[kt][r] > -1e29f) ? ex2(sc[kt][r] - mx) : 0.f; sc[kt][r] = p; ls += p; }
            ls += __shfl_xor(ls, 32);
            const float inv = ls > 0.f ? 1.0f / ls : 0.f;
#pragma unroll
            for (int kt = 0; kt < 4; ++kt)
#pragma unroll
                for (int r = 0; r < 16; ++r) sc[kt][r] *= inv;
            f32x16 out[2];
#pragma unroll
            for (int r = 0; r < 16; ++r) { out[0][r] = 0.f; out[1][r] = 0.f; }
#pragma unroll
            for (int kh = 0; kh < 2; ++kh) {
                load_v(ct[2 * kh], (const char*)VTC + ((size_t)bg * 4 + 2 * kh) * 4096, loff); load_v(ct[2 * kh + 1], (const char*)VTC + ((size_t)bg * 4 + 2 * kh + 1) * 4096, loff);
                attn_pv(sc[2 * kh], out, ct[2 * kh]); attn_pv(sc[2 * kh + 1], out, ct[2 * kh + 1]);
                asm volatile("" ::: "memory"); }
#pragma unroll
            for (int dt = 0; dt < 2; ++dt)
#pragma unroll
                for (int r = 0; r < 16; ++r) ost[(dt * 16 + r) * 64] = out[dt][r] * g_cmp;
            asm volatile("" ::: "memory");
            if (qblk < 8) sel = (2u << qblk) - 1u;
            else {
                float g4[16], lastv[16], lp[16]; unsigned key[16];
#pragma unroll
                for (int kt = 0; kt < 4; ++kt)
#pragma unroll
                    for (int q4 = 0; q4 < 4; ++q4) { g4[kt * 4 + q4] = (sc[kt][4 * q4] + sc[kt][4 * q4 + 1]) + (sc[kt][4 * q4 + 2] + sc[kt][4 * q4 + 3]); lastv[kt * 4 + q4] = sc[kt][4 * q4 + 3]; }
#pragma unroll
                for (int i = 0; i < 16; ++i) { g4[i] = sum8_dpp(g4[i]); lastv[i] = sum8_dpp(lastv[i]); }
#pragma unroll
                for (int i = 0; i < 16; ++i) lp[i] = __shfl_xor(lastv[i], 32);
#pragma unroll
                for (int i = 0; i < 16; ++i) { const int j = 2 * i + hi; const float prev = hi ? lp[i] : (i > 0 ? lp[i > 0 ? i - 1 : 0] : 0.f); const float imp = g4[i] + prev;
                    key[i] = (j >= 1 && j <= qblk - 2) ? ((__builtin_bit_cast(unsigned, imp) & ~31u) | (unsigned)(31 - j)) : 0u; }
                sel = 1u | (1u << qblk) | (1u << (qblk - 1));
#pragma unroll
                for (int it = 0; it < 5; ++it) { unsigned lm = key[0];
#pragma unroll
                    for (int i = 1; i < 16; ++i) lm = lm > key[i] ? lm : key[i];
                    const unsigned pm = __shfl_xor(lm, 32), gm = lm > pm ? lm : pm;
                    sel |= 1u << (31 - (gm & 31u));
#pragma unroll
                    for (int i = 0; i < 16; ++i) key[i] = (key[i] == gm) ? 0u : key[i]; }
            }
        }
        {
            const unsigned U = (unsigned)__builtin_amdgcn_readlane((int)sel, 0) | (unsigned)__builtin_amdgcn_readlane((int)sel, 8) | (unsigned)__builtin_amdgcn_readlane((int)sel, 16) | (unsigned)__builtin_amdgcn_readlane((int)sel, 24);
            unsigned long long x = U;
            x = (x | (x << 16)) & 0x0000FFFF0000FFFFull; x = (x | (x << 8)) & 0x00FF00FF00FF00FFull; x = (x | (x << 4)) & 0x0F0F0F0F0F0F0F0Full; x = (x | (x << 2)) & 0x3333333333333333ull; x = (x | (x << 1)) & 0x5555555555555555ull;
            const unsigned long long TM = (x | (x << 1)) & ((2ull << ((s0 + 3) >> 5)) - 1ull);
            attn_branch<0>(TM, (const char*)KFS + (size_t)bg * 64 * 4096, (const char*)VTS + (size_t)bg * 64 * 4096, loff, qr, ost, g_slc, sel, s0, stok, hi, lut_h, c31);
        }
        {
            const int tthi = s0 >> 5; int ttlo = (s0 - 511 - 31 + 31) >> 5; if (s0 - 511 - 31 < 0) ttlo = 0;
            const unsigned long long TM = ((2ull << tthi) - 1ull) & ~((1ull << ttlo) - 1ull);
            attn_branch<1>(TM, (const char*)KFW + (size_t)bg * 64 * 4096, (const char*)VTW + (size_t)bg * 64 * 4096, loff, qr, ost, g_win, sel, s0, stok, hi, lut_h, c31);
        }
#pragma unroll
        for (int dt = 0; dt < 2; ++dt)
#pragma unroll
            for (int q4 = 0; q4 < 4; ++q4) { const int rb = (dt * 16 + 4 * q4) * 64; u32x2 wv; wv.x = pk2(ost[rb], ost[rb + 64]); wv.y = pk2(ost[rb + 128], ost[rb + 192]);
                *(u32x2*)(O + row * DM + h * 64 + dt * 32 + 8 * q4 + 4 * hi) = wv; }
    }
    if (w >= 4) tr_run(a, F.ws, slab ? 2 : 1, F.vcu * NWAVES + w, F.G * NWAVES, scr, lane_id_fresh());
}

__device__ __forceinline__ void route_phase(Frame& F, KArgs a, int l2, int layer, const bf16_t* xbcur) {
    const float* wr = a->in[28] + (size_t)l2 * 1024 * 8; const float* gain = a->in[3] + (size_t)layer * 1024;
    unsigned* cnt = F.ctl + CW_CNT + l2 * 8 * 64;
    int* tok_slot = (int*)(F.ws + WS_RT); float* slot_rs = (float*)(F.ws + WS_RT + 256 * 1024); float* slot_c = (float*)(F.ws + WS_RT + 768 * 1024);
    bf16_t* XG = (bf16_t*)(F.ws + WS_XG);
    LAS int* re = (LAS int*)(F.lds + RING_OFF);
    LAS float* rw = (LAS float*)(F.lds + RING_OFF + 512);
    LAS float* rrs = (LAS float*)(F.lds + RING_OFF + 1024);
    LAS int* cwv = (LAS int*)(F.lds + RING_OFF + 1280);
    LAS int* basel = (LAS int*)(F.lds + RING_OFF + 1344);
    LAS int* sl = (LAS int*)(F.lds + RING_OFF + 1408);
    const int lane = F.lane, w = F.wave;
    for (int grp = opaque_s((int)blockIdx.x); grp < M / 64; grp += F.G) {
        __syncthreads();
        for (int jh = 0; jh < 2; ++jh) {
            u32x2 xq[4][4];
#pragma unroll
            for (int q = 0; q < 4; ++q)
#pragma unroll
                for (int jj = 0; jj < 4; ++jj) xq[q][jj] = ((const u32x2*)(xbcur + (size_t)(grp * 64 + w * 8 + jh * 4 + q) * DM) + lane)[64 * jj];
#pragma unroll
            for (int q = 0; q < 4; ++q) {
            const int tl = w * 8 + jh * 4 + q; const f32x4* gr = (const f32x4*)gain + lane;
            float ss = 0.f, lg[8] = {0.f, 0.f, 0.f, 0.f, 0.f, 0.f, 0.f, 0.f};
#pragma unroll
            for (int jj = 0; jj < 4; ++jj) { const u32x2 xw = xq[q][jj]; const f32x4 v = {bflo(xw.x), bfhi(xw.x), bflo(xw.y), bfhi(xw.y)}, gg = gr[64 * jj]; ss += (v[0] * v[0] + v[1] * v[1]) + (v[2] * v[2] + v[3] * v[3]);
#pragma unroll
                for (int e4 = 0; e4 < 4; ++e4) { const float xg = v[e4] * gg[e4]; const f32x4* wp = (const f32x4*)(wr + (size_t)(256 * jj + 4 * lane + e4) * 8); const f32x4 w0 = wp[0], w1 = wp[1];
                    lg[0] += xg * w0[0]; lg[1] += xg * w0[1]; lg[2] += xg * w0[2]; lg[3] += xg * w0[3]; lg[4] += xg * w1[0]; lg[5] += xg * w1[1]; lg[6] += xg * w1[2]; lg[7] += xg * w1[3]; } }
            ss = wave_sum(ss);
#pragma unroll
            for (int e = 0; e < 8; ++e) lg[e] = wave_sum(lg[e]);
            const float rstd = __builtin_amdgcn_rsqf(ss * (1.0f / 1024.0f) + EPS);
            int e1 = 0; float v1 = lg[0];
#pragma unroll
            for (int e = 1; e < 8; ++e) if (lg[e] > v1) { v1 = lg[e]; e1 = e; }
            int e2 = -1; float v2 = -3.0e38f;
#pragma unroll
            for (int e = 0; e < 8; ++e) if (e != e1 && lg[e] > v2) { v2 = lg[e]; e2 = e; }
            const float ex = __expf((v2 - v1) * rstd), w1 = 1.0f / (1.0f + ex), w2 = ex * w1;
            if (lane == 0) { re[tl * 2] = e1; re[tl * 2 + 1] = e2; rw[tl * 2] = w1; rw[tl * 2 + 1] = w2; rrs[tl] = rstd; }
            }
        }
        __syncthreads();
        int myrank = 0, mye = 0;
        if (F.tid < 128) { mye = re[F.tid];
#pragma unroll
            for (int e = 0; e < 8; ++e) { const unsigned long long mk = __ballot(mye == e); if (mye == e) myrank = __popcll(mk & ((1ull << lane) - 1ull)); if (lane == 0) cwv[w * 8 + e] = __popcll(mk); } }
        __syncthreads();
        if (F.tid < 8) basel[F.tid] = (int)__hip_atomic_fetch_add(cnt + F.tid * 64, (unsigned)(cwv[F.tid] + cwv[8 + F.tid]), __ATOMIC_RELAXED, __HIP_MEMORY_SCOPE_AGENT);
        __syncthreads();
        if (F.tid < 128) { const int tl = F.tid >> 1, t = grp * 64 + tl; const int pos = basel[mye] + (w == 1 ? cwv[mye] : 0) + myrank; const int slot = mye * M + pos;
            tok_slot[t * 2 + (F.tid & 1)] = slot; slot_c[t * 2 + (F.tid & 1)] = rw[F.tid]; sl[F.tid] = slot; }
        __syncthreads();
        for (int i = w * 16; i < w * 16 + 16; ++i) { const int t = grp * 64 + (i >> 1); const int slot = sl[i]; const float rn = rrs[i >> 1];
#pragma unroll
            for (int hh = 0; hh < 2; ++hh) { const u32x4 v = *((const u32x4*)(xbcur + (size_t)t * DM) + lane + 64 * hh);
                u32x2 o; int t0 = __builtin_amdgcn_cvt_pk_fp8_f32(bflo(v.x) * rn, bfhi(v.x) * rn, 0, false); t0 = __builtin_amdgcn_cvt_pk_fp8_f32(bflo(v.y) * rn, bfhi(v.y) * rn, t0, true);
                int t1 = __builtin_amdgcn_cvt_pk_fp8_f32(bflo(v.z) * rn, bfhi(v.z) * rn, 0, false); t1 = __builtin_amdgcn_cvt_pk_fp8_f32(bflo(v.w) * rn, bfhi(v.w) * rn, t1, true); o.x = (unsigned)t0; o.y = (unsigned)t1;
                *((u32x2*)((unsigned char*)XG + (size_t)slot * DM) + lane + 64 * hh) = o; } }
    }
}
__device__ __forceinline__ void moe_table(Frame& F, int l2, int nN, int xown) {
    LAS int* tb = (LAS int*)(F.MISC + 16);
    __syncthreads();
    if (F.tid == 0) { const unsigned* cnt = F.ctl + CW_CNT + l2 * 8 * 64; int seg = 0, cum = 0; const int x = (int)blockIdx.x & 7;
        for (int e = 0; e < 8; ++e) { const int n = (int)__hip_atomic_load(cnt + e * 64, __ATOMIC_RELAXED, __HIP_MEMORY_SCOPE_AGENT); const int te = (n + 255) >> 8;
            const int ncol = xown ? ((((x + e) & 7) < (nN & 7)) ? (nN >> 3) + 1 : (nN >> 3)) : nN;
            tb[e] = te; tb[8 + e] = seg; tb[16 + e] = cum; seg += te * 256; cum += te * ncol; }
        tb[24] = cum; }
    __syncthreads();
}
__device__ __forceinline__ void combine_phase(Frame& F, const bf16_t* xbc, bf16_t* xbn, float* ssn) {
    const bf16_t* YM = (const bf16_t*)(F.ws + WS_YM); const int* tok_slot = (const int*)(F.ws + WS_RT); const float* tok_w = (const float*)(F.ws + WS_RT + 768 * 1024);
    const LAS int* tb = (const LAS int*)(F.MISC + 16);
    const int gw = F.vcu * NWAVES + F.wave, NGW = F.G * NWAVES;
    for (int t0 = gw * 4; t0 < M; t0 += NGW * 4) {
        int s1[4], s2[4]; float c1[4], c2[4];
#pragma unroll
        for (int q = 0; q < 4; ++q) { s1[q] = tok_slot[(t0 + q) * 2]; s2[q] = tok_slot[(t0 + q) * 2 + 1]; c1[q] = tok_w[(t0 + q) * 2]; c2[q] = tok_w[(t0 + q) * 2 + 1]; }
        u32x2 xw[4][4], a1[4][4], a2[4][4];
#pragma unroll
        for (int q = 0; q < 4; ++q) { const size_t r1 = (size_t)tb[8 + (s1[q] >> 14)] + (s1[q] & (M - 1)), r2 = (size_t)tb[8 + (s2[q] >> 14)] + (s2[q] & (M - 1));
#pragma unroll
            for (int j = 0; j < 4; ++j) { xw[q][j] = ((const u32x2*)(xbc + (size_t)(t0 + q) * DM) + F.lane)[64 * j]; a1[q][j] = ((const u32x2*)(YM + r1 * DM) + F.lane)[64 * j]; a2[q][j] = ((const u32x2*)(YM + r2 * DM) + F.lane)[64 * j]; } }
#pragma unroll
        for (int q = 0; q < 4; ++q) { u32x2* o8 = (u32x2*)(xbn + (size_t)(t0 + q) * DM) + F.lane; float s = 0.f;
#pragma unroll
            for (int j = 0; j < 4; ++j) { f32x4 v;
                v[0] = bflo(xw[q][j].x) + c1[q] * bflo(a1[q][j].x) + c2[q] * bflo(a2[q][j].x); v[1] = bfhi(xw[q][j].x) + c1[q] * bfhi(a1[q][j].x) + c2[q] * bfhi(a2[q][j].x);
                v[2] = bflo(xw[q][j].y) + c1[q] * bflo(a1[q][j].y) + c2[q] * bflo(a2[q][j].y); v[3] = bfhi(xw[q][j].y) + c1[q] * bfhi(a1[q][j].y) + c2[q] * bfhi(a2[q][j].y);
                u32x2 wv; wv.x = pk2(v[0], v[1]); wv.y = pk2(v[2], v[3]); o8[64 * j] = wv; s += (v[0] * v[0] + v[1] * v[1]) + (v[2] * v[2] + v[3] * v[3]); }
            s = wave_sum(s);
            if (F.lane < 16) ssn[(size_t)(t0 + q) * 16 + F.lane] = (F.lane == 0) ? s : 0.f; }
    }
}
__device__ __forceinline__ void vtrans_phase(Frame& F) {
    const bf16_t* KVQ = (const bf16_t*)(F.ws + WS_GXK);
    const int gw = F.vcu * NWAVES + F.wave, NGW = F.G * NWAVES, lane = F.lane, l31 = lane & 31, hi = lane >> 5;
    for (int it = gw; it < 2048; it += NGW) {
        const int which = it >> 10, bg = (it >> 6) & 15, tt = it & 63, b = bg >> 1, g = bg & 1;
        const bf16_t* src = KVQ + ((size_t)b * SEQ + tt * 32) * NKVQ + g * 64;
        bf16_t* KF = (bf16_t*)(F.ws + (which ? WS_KFW : WS_KFS)) + ((size_t)bg * 64 + tt) * 2048 + lane * 8;
        bf16_t* VF = (bf16_t*)(F.ws + (which ? WS_VTW : WS_VTS)) + ((size_t)bg * 64 + tt) * 2048 + lane * 8;
        const int kcol = which ? 512 : 256, vcol = which ? 640 : 384;
        u32x4 kv[4];
#pragma unroll
        for (int d0 = 0; d0 < 4; ++d0) kv[d0] = *(const u32x4*)(src + (size_t)l31 * NKVQ + kcol + d0 * 16 + hi * 8);
#pragma unroll
        for (int dt = 0; dt < 2; ++dt)
#pragma unroll
            for (int s2 = 0; s2 < 2; ++s2) { unsigned short e8[8];
#pragma unroll
                for (int e = 0; e < 8; ++e) e8[e] = src[(size_t)(16 * s2 + 8 * (e >> 2) + 4 * hi + (e & 3)) * NKVQ + vcol + dt * 32 + l31];
                u32x4 o; o.x = e8[0] | ((unsigned)e8[1] << 16); o.y = e8[2] | ((unsigned)e8[3] << 16); o.z = e8[4] | ((unsigned)e8[5] << 16); o.w = e8[6] | ((unsigned)e8[7] << 16);
                *(u32x4*)(VF + (dt * 2 + s2) * 512) = o; }
#pragma unroll
        for (int d0 = 0; d0 < 4; ++d0) *(u32x4*)(KF + d0 * 512) = kv[d0];
    }
}
__device__ __forceinline__ void cmp2_phase(Frame& F, KArgs a) {
    const float* HP = (const float*)(F.ws + WS_H); const float* cbias = (const float*)(F.ws + WS_SMALL); bf16_t* KC = (bf16_t*)(F.ws + WS_KC); bf16_t* VTC = KC + 16 * 128 * 64;
    LAS float* hid = (LAS float*)(F.lds + RING_OFF);
    for (int grp = opaque_s((int)blockIdx.x); grp < 256; grp += F.G) {
        const int kv = grp >> 7, row0 = (grp & 127) * 16;
        __syncthreads();
#pragma unroll
        for (int i = 0; i < 2; ++i) { const int idx = F.tid + i * 512, rl = idx >> 6, j4 = (idx & 63) * 4;
            f32x4 sacc = *(const f32x4*)(cbias + kv * 256 + j4);
#pragma unroll
            for (int ks = 0; ks < 8; ++ks) sacc += *(const f32x4*)(HP + ((size_t)(ks * 2 + kv) * 2048 + row0 + rl) * 256 + j4);
#pragma unroll
            for (int e = 0; e < 4; ++e) sacc[e] = gelu_tanh(sacc[e]);
            *(LAS f32x4*)(hid + rl * 256 + j4) = sacc; }
        __syncthreads();
        const float* w2 = a->in[kv ? 22 : 20];
#pragma unroll
        for (int i = 0; i < 2; ++i) { const int idx = F.tid + i * 512, rl = idx >> 6, d = idx & 63, rowi = row0 + rl, c = rowi & 127, bg = rowi >> 7;
            float s = 0.f;
#pragma unroll 8
            for (int j = 0; j < 256; ++j) s += hid[rl * 256 + j] * w2[(size_t)j * 64 + d];
            if (c == 127) s = 0.f;
            const int kt = c >> 5, k = c & 31;
            if (kv == 0) KC[(((size_t)bg * 4 + kt) * 4 + (d >> 4)) * 512 + ((((d >> 3) & 1) * 32) + k) * 8 + (d & 7)] = (bf16_t)f2bf(s);
            else { const int s2 = k >> 4, kk = k & 15; VTC[((((size_t)bg * 4 + kt) * 2 + (d >> 5)) * 2 + s2) * 512 + ((((kk >> 2) & 1) * 32) + (d & 31)) * 8 + 4 * (kk >> 3) + (kk & 3)] = (bf16_t)f2bf(s); } }
    }
}
__device__ __forceinline__ void quant_phase(Frame& F, KArgs a, int ld, const bf16_t* xbc) {
    unsigned* XQ = (unsigned*)(F.ws + WS_XQ); float* rowf = (float*)(F.ws + WS_ROWF);
    const int gw = F.vcu * NWAVES + F.wave, NGW = F.G * NWAVES;
    for (int m0 = gw * 4; m0 < M; m0 += NGW * 4) {
        u32x2 xw[4][4];
#pragma unroll
        for (int q = 0; q < 4; ++q)
#pragma unroll
            for (int j = 0; j < 4; ++j) xw[q][j] = ((const u32x2*)(xbc + (size_t)(m0 + q) * DM) + F.lane)[64 * j];
#pragma unroll
        for (int q = 0; q < 4; ++q) { f32x4 v[4]; float s = 0.f, mx = 0.f;
#pragma unroll
            for (int j = 0; j < 4; ++j) { v[j] = (f32x4){bflo(xw[q][j].x), bfhi(xw[q][j].x), bflo(xw[q][j].y), bfhi(xw[q][j].y)}; s += (v[j][0] * v[j][0] + v[j][1] * v[j][1]) + (v[j][2] * v[j][2] + v[j][3] * v[j][3]);
                mx = fmaxf(mx, fmaxf(fmaxf(fabsf(v[j][0]), fabsf(v[j][1])), fmaxf(fabsf(v[j][2]), fabsf(v[j][3])))); }
            s = wave_sum(s);
#pragma unroll
            for (int o = 1; o < 64; o <<= 1) mx = fmaxf(mx, __shfl_xor(mx, o));
            const float rstd = __builtin_amdgcn_rsqf(s * (1.0f / 1024.0f) + EPS), qsc = mx > 0.f ? 127.0f / mx : 0.f;
#pragma unroll
            for (int j = 0; j < 4; ++j) { const int q0 = (int)__builtin_rintf(v[j][0] * qsc), q1 = (int)__builtin_rintf(v[j][1] * qsc), q2 = (int)__builtin_rintf(v[j][2] * qsc), q3 = (int)__builtin_rintf(v[j][3] * qsc);
                (XQ + (size_t)(m0 + q) * (DM / 4) + F.lane)[64 * j] = (unsigned)(q0 & 0xFF) | ((unsigned)(q1 & 0xFF) << 8) | ((unsigned)(q2 & 0xFF) << 16) | ((unsigned)(q3 & 0xFF) << 24); }
            if (F.lane == 0) rowf[m0 + q] = mx * rstd * (1.0f / 127.0f); }
    }
    LAS unsigned* scr = (LAS unsigned*)(F.lds + RING_OFF + F.wave * 16384);
    tr_run(a, F.ws, 3 + ld, gw, NGW, scr, F.lane);
}
__device__ __forceinline__ void final_phase(Frame& F, KArgs a, const bf16_t* xbc) {
    const float* gf = a->in[5];
    const int gw = F.vcu * NWAVES + F.wave, NGW = F.G * NWAVES;
    for (int m0 = gw * 4; m0 < M; m0 += NGW * 4) {
        u32x2 xw[4][4];
#pragma unroll
        for (int q = 0; q < 4; ++q)
#pragma unroll
            for (int j = 0; j < 4; ++j) xw[q][j] = ((const u32x2*)(xbc + (size_t)(m0 + q) * DM) + F.lane)[64 * j];
#pragma unroll
        for (int q = 0; q < 4; ++q) { f32x4 v[4]; float s = 0.f; f32x4* orow = (f32x4*)(a->out + (size_t)(m0 + q) * DM) + F.lane; const f32x4* gr = (const f32x4*)gf + F.lane;
#pragma unroll
            for (int j = 0; j < 4; ++j) { v[j] = (f32x4){bflo(xw[q][j].x), bfhi(xw[q][j].x), bflo(xw[q][j].y), bfhi(xw[q][j].y)}; s += (v[j][0] * v[j][0] + v[j][1] * v[j][1]) + (v[j][2] * v[j][2] + v[j][3] * v[j][3]); }
            const float rstd = __builtin_amdgcn_rsqf(wave_sum(s) * (1.0f / 1024.0f) + EPS);
#pragma unroll
            for (int j = 0; j < 4; ++j) orow[64 * j] = v[j] * rstd * gr[64 * j]; }
    }
}
#ifndef MK_PER_PHASE
#define MK_PER_PHASE 0
#endif
#ifndef MK_KMASK
#define MK_KMASK 0xFFFFFFFFu
#endif
#define KIND(k) ((MK_KMASK >> (k)) & 1u)

constexpr int N_PHASES = 34;
#ifndef MK_NOINLINE
#define PHFN static __device__ __forceinline__ void
#else
#define PHFN static __device__ __attribute__((noinline)) void
#endif
#define XBV(k) ((bf16_t*)(ws + ((k) ? WS_XB1 : WS_XB0)))
#define SSV(k) ((float*)(ws + ((k) ? WS_SS1 : WS_SS0)))
#define WSP(T, off) ((T*)(ws + (off)))
#define GEO1K pg8::Geo{1024, 2048u, 2048u, 128u, 128u, (size_t)128 * 2048, (size_t)128 * 2048}
__device__ __forceinline__ Frame mk_frame(LAS unsigned char* lds, unsigned char* ws, int wv) {
    Frame F; F.lds = lds; F.MISC = (volatile LAS unsigned*)(lds + MISC_OFF);
    F.wave = opaque_s(wv); F.lane = opaque_v(lane_id()); F.tid = F.wave * 64 + F.lane;
    F.G = opaque_s((int)gridDim.x); { const int bx = opaque_s((int)blockIdx.x); F.vcu = (F.G % 8 == 0) ? (bx % 8) * (F.G / 8) + bx / 8 : bx; }
    F.ws = ws; F.ctl = (unsigned*)(ws + WS_CTL); return F;
}
PHFN ph_prologue(LAS unsigned char* lds, unsigned char* ws, int wv, KArgs kap) { Frame F = mk_frame(lds, ws, wv); p0_prologue(F, kap); }
__device__ __forceinline__ void pp_units(LAS unsigned char* lds, unsigned char* ws, int wv, int l0, int nl, int wg0) {
    const pg8::Geo g{256, 512u, 512u, 128u, 128u, (size_t)128 * 512, (size_t)128 * 512};
    pg8::StdOrder S{(const char*)(ws + WS_PB) + (size_t)l0 * M * 512, (const char*)(ws + WS_WPP) + (size_t)l0 * 1024 * 256 * 2, (size_t)256 * 512, (size_t)256 * 512, 64 * nl, 4, 256 * nl,
                    opaque_s((int)gridDim.x) - wg0, opaque_s((int)blockIdx.x) - wg0, l0 * M, 0, 256, 64, (size_t)1024 * 256 * 2, 0, 0, 0, 0};
    pg8::EpiAct E{WSP(bf16_t, WS_PP), 1024, nullptr, 1.0f};
    pg8::gemm_phase(lds + RING_OFF, g, S, E, wv);
}
PHFN ph_win(LAS unsigned char* lds, unsigned char* ws, int wv, int L, int v) {
    pg8::StdOrder S{(const char*)XBV(v), (const char*)(ws + WS_WIN) + (size_t)L * 2048 * 1024 * 2, (size_t)256 * 2048, (size_t)256 * 2048, 64, 8, 512, opaque_s((int)gridDim.x), opaque_s((int)blockIdx.x), 0, 0, 256, 0, 0, 0, 4, 0, 0};
    pg8::EpiAct E{WSP(bf16_t, WS_GXK), 2048, SSV(v), 1.0f};
    pg8::gemm_phase(lds + RING_OFF, GEO1K, S, E, wv);
    if (L == 0) pp_units(lds, ws, wv, 0, 1, 0);
}
PHFN ph_rg(LAS unsigned char* lds, unsigned char* ws, int wv, KArgs kap, int L) { Frame F = mk_frame(lds, ws, wv); rg_phase(F, kap, L); }
PHFN ph_resid(LAS unsigned char* lds, unsigned char* ws, int wv, const float* x32, size_t a_off, size_t b_off, int K, int v) {
    const pg8::Geo g{K, (unsigned)K * 2u, (unsigned)K * 2u, 128u, 128u, (size_t)128 * K * 2, (size_t)128 * K * 2};
    pg8::StdOrder S{(const char*)(ws + a_off), (const char*)(ws + b_off), (size_t)256 * K * 2, (size_t)256 * K * 2, 64, 4, 256, opaque_s((int)gridDim.x), opaque_s((int)blockIdx.x), 0, 0, 256, 0, 0, 0, 0, 0, 0};
    pg8::EpiResid<0> E{x32, XBV(v), XBV(v ^ 1), SSV(v ^ 1), nullptr, nullptr};
    pg8::gemm_phase(lds + RING_OFF, g, S, E, wv);
}
PHFN ph_qproj(LAS unsigned char* lds, unsigned char* ws, int wv, int L, int v) {
    const int first = (L == 2) ? 0 : 3, ntile = (L == 2) ? 8 : 4;
    pg8::StdOrder S{(const char*)XBV(v), (const char*)(ws + WS_WKVQ) + ((size_t)(L - 2) * 2048 + first * 256) * 1024 * 2, (size_t)256 * 2048, (size_t)256 * 2048, 64, ntile, 64 * ntile, opaque_s((int)gridDim.x), opaque_s((int)blockIdx.x),
                    0, first * 256, 256, 0, 0, 0, 0, 3 - first, 7 - first};
    pg8::EpiAct E{WSP(bf16_t, WS_GXK), 2048, SSV(v), 1.0f};
    pg8::gemm_phase(lds + RING_OFF, GEO1K, S, E, wv);
    if (L == 3) {
        const pg8::Geo g{256, 2048u, 2048u, 128u, 128u, (size_t)128 * 2048, (size_t)128 * 2048};
        pg8::GateOrder S2{(const char*)XBV(v), (const char*)(ws + WS_WKVQ) + ((size_t)2048 + 1792) * 1024 * 2, opaque_s((int)gridDim.x), opaque_s((int)blockIdx.x)};
        pg8::EpiGateSlab E2{WSP(float, WS_GS), SSV(v)};
        pg8::gemm_phase(lds + RING_OFF, g, S2, E2, wv);
    }
}
PHFN ph_vtrans(LAS unsigned char* lds, unsigned char* ws, int wv) { Frame F = mk_frame(lds, ws, wv); vtrans_phase(F); }
PHFN ph_cmp1(LAS unsigned char* lds, unsigned char* ws, int wv) {
    const pg8::Geo g{256, 65536u, 4096u, 4096u, 128u, (size_t)128, (size_t)128 * 4096};
    pg8::CmpOrder S{(const char*)(ws + WS_GXK), (const char*)(ws + WS_WC1), opaque_s((int)blockIdx.x)};
    pg8::EpiCmp E{WSP(float, WS_H)};
    pg8::gemm_phase(lds + RING_OFF, g, S, E, wv);
}
PHFN ph_cmp2(LAS unsigned char* lds, unsigned char* ws, int wv, KArgs kap) { Frame F = mk_frame(lds, ws, wv); cmp2_phase(F, kap); }
PHFN ph_attn(LAS unsigned char* lds, unsigned char* ws, int wv, KArgs kap, int slab) { Frame F = mk_frame(lds, ws, wv); attn_phase(F, kap, slab); }
PHFN ph_quant(LAS unsigned char* lds, unsigned char* ws, int wv, KArgs kap, int L, int v) { Frame F = mk_frame(lds, ws, wv); quant_phase(F, kap, L >> 1, XBV(v)); }
PHFN ph_gu(LAS unsigned char* lds, unsigned char* ws, int wv, int L, int v) {
    const pg8::Geo g{1024, 1024u, 1024u, 128u, 128u, (size_t)128 * 1024, (size_t)128 * 1024};
    pg8::StdOrder S{(const char*)(ws + WS_XQ), (const char*)(ws + WS_WGU) + (size_t)(L >> 1) * 6144 * 1024, (size_t)256 * 1024, (size_t)256 * 1024, 64, 24, 1536, opaque_s((int)gridDim.x), opaque_s((int)blockIdx.x), 0, 0, 128, 0, 0, 0, 0, 0, 0};
    const float wm = __builtin_bit_cast(float, __hip_atomic_load((unsigned*)ws + CW_WMAX + 64 * (L >> 1), __ATOMIC_RELAXED, __HIP_MEMORY_SCOPE_AGENT));
    pg8::EpiGatedI8 E{WSP(bf16_t, WS_H), 3072, WSP(const float, WS_ROWF), wm * (1.0f / 127.0f)};
    pg8::gemm_phase_i8(lds + RING_OFF, g, S, E, wv);
}
PHFN ph_route(LAS unsigned char* lds, unsigned char* ws, int wv, KArgs kap, int L, int v) { Frame F = mk_frame(lds, ws, wv); route_phase(F, kap, L >> 1, L, XBV(v)); }
PHFN ph_mgu(LAS unsigned char* lds, unsigned char* ws, int wv, int l2) {
    Frame F = mk_frame(lds, ws, wv); const int xown = ((int)gridDim.x % 8 == 0) ? 1 : 0; moe_table(F, l2, 28, xown);
    const pg8::Geo g{1024, 1024u, 1024u, 128u, 128u, (size_t)128 * 1024, (size_t)128 * 1024};
    pg8::MoeOrder S{(const LAS int*)(F.MISC + 16), (const char*)(ws + WS_XG), (const char*)(ws + WS_WMGU) + (size_t)l2 * 8 * 7168 * 1024, (size_t)1024, (size_t)1024, opaque_s((int)gridDim.x), opaque_s((int)blockIdx.x), 28, 7168, 128, 0, xown};
    pg8::EpiGated<1> E{WSP(bf16_t, WS_H), 3584, nullptr, (const float*)(ws + WS_RT + 256 * 1024), (const float*)(ws + WS_RT + 768 * 1024)};
    if (DUP(29)) { const pg8::Geo g0{1024, 1024u, 1024u, 0u, 0u, (size_t)128 * 1024, (size_t)128 * 1024}; pg8::gemm_phase_f8(lds + RING_OFF, g0, S, E, wv); }
    pg8::gemm_phase_f8(lds + RING_OFF, g, S, E, wv);
}
PHFN ph_mdown(LAS unsigned char* lds, unsigned char* ws, int wv, int l2) {
    Frame F = mk_frame(lds, ws, wv); moe_table(F, l2, 4, 0);
    const pg8::Geo g{3584, 3584u, 3584u, 128u, 128u, (size_t)128 * 3584, (size_t)128 * 3584};
    pg8::MoeOrder S{(const LAS int*)(F.MISC + 16), (const char*)(ws + WS_H), (const char*)(ws + WS_WMDN) + (size_t)l2 * 8 * 1024 * 3584, (size_t)3584, (size_t)3584, opaque_s((int)gridDim.x), opaque_s((int)blockIdx.x), 4, 1024, 256, 1, 0};
    pg8::EpiAct E{WSP(bf16_t, WS_YM), 1024, nullptr, 0.015625f};
    pg8::gemm_phase_f8(lds + RING_OFF, g, S, E, wv);
    { const int G_ = (int)gridDim.x, rem = ((const LAS int*)(F.MISC + 16))[24] % G_;
      if (l2 == 0) pp_units(lds, ws, wv, 1, 2, rem); else pp_units(lds, ws, wv, 3, 1, rem); }
}
PHFN ph_combine(LAS unsigned char* lds, unsigned char* ws, int wv, int l2, int v) { Frame F = mk_frame(lds, ws, wv); moe_table(F, l2, 4, 0); combine_phase(F, XBV(v), XBV(v ^ 1), SSV(v ^ 1)); }
PHFN ph_gate(LAS unsigned char* lds, unsigned char* ws, int wv, int L, int v) {
    pg8::StdOrder S{(const char*)XBV(v), (const char*)(ws + WS_WPG) + (size_t)L * 1024 * 1024 * 2, (size_t)256 * 2048, (size_t)256 * 2048, 64, 4, 256, opaque_s((int)gridDim.x), opaque_s((int)blockIdx.x), 0, 0, 256, 0, 0, 0, 0, 0, 0};
    pg8::EpiResid<1> E{nullptr, XBV(v), XBV(v ^ 1), SSV(v ^ 1), SSV(v), WSP(const bf16_t, WS_PP) + (size_t)L * M * DM};
    pg8::gemm_phase(lds + RING_OFF, GEO1K, S, E, wv);
}
PHFN ph_final(LAS unsigned char* lds, unsigned char* ws, int wv, KArgs kap, int v) { Frame F = mk_frame(lds, ws, wv); final_phase(F, kap, XBV(v)); }
PHFN ph_barrier(unsigned* barw, unsigned x, LAS unsigned* st, int wv) { XcdBarrier b; b.bar = barw; b.x = x; b.st = (volatile LAS unsigned*)st; xcd_barrier(b, wv); }

#define PH_RUN (ph >= lo && ph < hi)
#define PH_END do { if (ph >= lo && ph + 1 < hi) { ph_barrier(barw, bx, bst, wv); if (DUP(31)) ph_barrier(barw, bx, bst, wv); } ++ph; } while (0)
template <int L>
__device__ __forceinline__ void layer_body(LAS unsigned char* lds, unsigned char* ws, int wv, KArgs kap, const int lo, const int hi, int& ph, int& v, unsigned* barw, unsigned bx, LAS unsigned* bst) {
    if (L < 2) {
        if (KIND(2) && PH_RUN) { ph_win(lds, ws, wv, L, v); if (DUP(2)) ph_win(lds, ws, wv, L, v); }
        PH_END;
        if (KIND(3) && PH_RUN) { ph_rg(lds, ws, wv, kap, L); if (DUP(3)) ph_rg(lds, ws, wv, kap, L); }
        PH_END;
        if (KIND(4) && PH_RUN) { ph_resid(lds, ws, wv, L == 0 ? kap->in[0] : (const float*)nullptr, WS_YO, WS_WOUT + (size_t)L * 1024 * 1024 * 2, 1024, v);
            if (DUP(4) && L == 0) { ph_resid(lds, ws, wv, kap->in[0], WS_YO, WS_WOUT, 1024, v); ph_resid(lds, ws, wv, kap->in[0], WS_YO, WS_WOUT, 1024, v); ph_resid(lds, ws, wv, kap->in[0], WS_YO, WS_WOUT, 1024, v); ph_resid(lds, ws, wv, kap->in[0], WS_YO, WS_WOUT, 1024, v); } }
        PH_END; v ^= 1;
    } else {
        if (KIND(5) && PH_RUN) { ph_qproj(lds, ws, wv, L, v); if (DUP(5)) ph_qproj(lds, ws, wv, L, v); }
        PH_END;
        if (L == 2) {
            if (KIND(6) && PH_RUN) { ph_vtrans(lds, ws, wv); ph_cmp1(lds, ws, wv); if (DUP(6)) { ph_vtrans(lds, ws, wv); ph_cmp1(lds, ws, wv); } }
            PH_END;
            if (KIND(7) && PH_RUN) { ph_cmp2(lds, ws, wv, kap); if (DUP(7)) ph_cmp2(lds, ws, wv, kap); }
            PH_END;
        }
        if (KIND(8) && PH_RUN) { ph_attn(lds, ws, wv, kap, L == 3); if (DUP(8)) ph_attn(lds, ws, wv, kap, L == 3); }
        PH_END;
        if (KIND(9) && PH_RUN) ph_resid(lds, ws, wv, (const float*)nullptr, WS_YO, WS_WO + (size_t)(L - 2) * 1024 * 1024 * 2, 1024, v);
        PH_END; v ^= 1;
    }
    if ((L & 1) == 0) {
        if (KIND(10) && PH_RUN) ph_quant(lds, ws, wv, kap, L, v);
        PH_END;
        if (KIND(10) && PH_RUN) { ph_gu(lds, ws, wv, L, v); if (DUP(10)) ph_gu(lds, ws, wv, L, v); }
        PH_END;
        if (KIND(11) && PH_RUN) ph_resid(lds, ws, wv, (const float*)nullptr, WS_H, WS_WDN + (size_t)(L >> 1) * 1024 * 3072 * 2, 3072, v);
        PH_END; v ^= 1;
    } else {
        if (KIND(12) && PH_RUN) ph_route(lds, ws, wv, kap, L, v);
        PH_END;
        if (KIND(13) && PH_RUN) { ph_mgu(lds, ws, wv, L >> 1); if (DUP(13)) ph_mgu(lds, ws, wv, L >> 1); }
        PH_END;
        if (KIND(14) && PH_RUN) { ph_mdown(lds, ws, wv, L >> 1); if (DUP(14)) ph_mdown(lds, ws, wv, L >> 1); }
        PH_END;
        if (KIND(15) && PH_RUN) ph_combine(lds, ws, wv, L >> 1, v);
        PH_END; v ^= 1;
    }
    if (KIND(16) && PH_RUN) ph_gate(lds, ws, wv, L, v);
    PH_END; v ^= 1;
}
__global__ void __launch_bounds__(NWAVES * 64, 2) mega_fwd(Args args) {
    extern __shared__ __attribute__((aligned(16))) unsigned char lds_[];
    LAS unsigned char* lds = (LAS unsigned char*)lds_;
    KArgs kap = (KArgs)__builtin_amdgcn_kernarg_segment_ptr();
    unsigned char* ws = kap->ws;
    const int wv = __builtin_amdgcn_readfirstlane((int)threadIdx.x >> 6);
    for (int u = threadIdx.x; u < (LDS_BYTES - LDSCTL_OFF) / 4; u += NWAVES * 64) ((LAS unsigned*)(lds + LDSCTL_OFF))[u] = 0u;
    __syncthreads();
    const int lo = kap->ph_lo, hi = kap->ph_hi;
    unsigned* barw = (unsigned*)(ws + WS_CTL) + CW_BAR; LAS unsigned* bst = (LAS unsigned*)(lds + MISC_OFF) + 8; unsigned bx = 0;
    if (hi - lo > 1) { const XcdBarrier b = xcd_barrier_post(barw, (volatile LAS unsigned*)bst, wv); bx = b.x; }
    int ph = 0;
    int v = 0;
    if (KIND(0) && PH_RUN) { ph_prologue(lds, ws, wv, kap); if (DUP(0)) ph_prologue(lds, ws, wv, kap); }
    PH_END;
    layer_body<0>(lds, ws, wv, kap, lo, hi, ph, v, barw, bx, bst);
    layer_body<1>(lds, ws, wv, kap, lo, hi, ph, v, barw, bx, bst);
    layer_body<2>(lds, ws, wv, kap, lo, hi, ph, v, barw, bx, bst);
    layer_body<3>(lds, ws, wv, kap, lo, hi, ph, v, barw, bx, bst);
    if (KIND(17) && PH_RUN) { ph_final(lds, ws, wv, kap, v); if (DUP(17)) ph_final(lds, ws, wv, kap, v); }
    PH_END;
}
#undef PH_RUN
#undef PH_END

extern "C" void kernel_launch(void* const* d_in, const int* in_sizes, int n_in, void* d_out, int out_size, void* d_ws, size_t ws_size, hipStream_t stream) {
    static int grid = 0;
    if (grid == 0) {
        if (n_in != 33 || out_size != M * DM || ws_size < WS_END) { fprintf(stderr, "kernel_launch: unexpected shapes (n_in %d, out %d, ws %zu < %zu)\n", n_in, out_size, ws_size, (size_t)WS_END); grid = -1; return; }
        int dev = 0, cus = 0, per_cu = 0;
        if (hipGetDevice(&dev) != hipSuccess || hipDeviceGetAttribute(&cus, hipDeviceAttributeMultiprocessorCount, dev) != hipSuccess) { grid = -1; return; }
        if (hipFuncSetAttribute((const void*)mega_fwd, hipFuncAttributeMaxDynamicSharedMemorySize, LDS_BYTES) != hipSuccess) { fprintf(stderr, "kernel_launch: hipFuncSetAttribute failed\n"); grid = -1; return; }
        if (hipOccupancyMaxActiveBlocksPerMultiprocessor(&per_cu, (const void*)mega_fwd, NWAVES * 64, LDS_BYTES) != hipSuccess || per_cu < 1) { fprintf(stderr, "kernel_launch: occupancy query says %d\n", per_cu); }
        (void)hipGetLastError();
        grid = cus;
    }
    if (grid < 0) return;
    (void)hipMemsetAsync((char*)d_ws + WS_CTL, 0, CTL_ZERO_BYTES, stream);
    Args a{};
    for (int i = 0; i < 33; ++i) a.in[i] = (const float*)d_in[i];
    a.out = (float*)d_out; a.ws = (unsigned char*)d_ws;
#if MK_PER_PHASE
    for (int p = 0; p < N_PHASES; ++p) { a.ph_lo = p; a.ph_hi = p + 1; hipLaunchKernelGGL(mega_fwd, dim3(grid), dim3(NWAVES * 64), LDS_BYTES, stream, a); }
#else
    a.ph_lo = 0; a.ph_hi = N_PHASES;
    hipLaunchKernelGGL(mega_fwd, dim3(grid), dim3(NWAVES * 64), LDS_BYTES, stream, a);
#endif
}
```
